# Optimizing an MI355X kernel written in HIP

```python
import math
import jax, jax.numpy as jnp
from jax import lax
import numpy as np

D_MODEL = 1024
BATCH = 16
SEQ = 2048
DEPTH = 1
DEC_BATCH = 16
DEC_SEQ = 4096
PAST_LEN = 128

N_MEM = 256
S5_WIDTH = D_MODEL
S5_GROUP = 16
S5_GROUPS = S5_WIDTH // S5_GROUP
S5_STATE = 64
S5_CHUNK = 128
DT_MIN = 1e-3
DT_MAX = 1e-1
DIFF_HEADS = 8
DIFF_DH = D_MODEL // DIFF_HEADS // 2
DIFF_WIDTH = DIFF_HEADS * 2 * DIFF_DH
Q_BLOCK = 128
ROPE_THETA = 10000.0
MEM_HEADS = 4
MEM_DH = D_MODEL // MEM_HEADS
MEM_WIDTH = MEM_HEADS * MEM_DH
N_BRANCH = 3
D_FF = -(-8 * D_MODEL // (3 * 256)) * 256
IN_COLS = S5_WIDTH + 3 * DIFF_WIDTH + MEM_WIDTH + N_BRANCH * D_MODEL
SPLITS = [S5_WIDTH, S5_WIDTH + DIFF_WIDTH, S5_WIDTH + 2 * DIFF_WIDTH, S5_WIDTH + 3 * DIFF_WIDTH, S5_WIDTH + 3 * DIFF_WIDTH + MEM_WIDTH]
EPS = 1e-6

kernel_name = "hybrid_s5_diffattn_memxattn_encoder"

F32 = jnp.float32


def rmsnorm(x, g):
    xf = x.astype(F32)
    y = xf * lax.rsqrt(jnp.mean(xf * xf, axis=-1, keepdims=True) + EPS)
    return (y * g.astype(F32)).astype(x.dtype)


def rope(x):
    L, dh = x.shape[1], x.shape[-1]
    half = dh // 2
    inv = ROPE_THETA ** (-jnp.arange(half, dtype=F32) / half)
    ang = jnp.arange(L, dtype=F32)[:, None] * inv[None, :]
    cos = jnp.cos(ang)[None, :, None, :]
    sin = jnp.sin(ang)[None, :, None, :]
    xf = x.astype(F32)
    x1, x2 = xf[..., :half], xf[..., half:]
    return jnp.concatenate([x1 * cos - x2 * sin, x1 * sin + x2 * cos], axis=-1).astype(x.dtype)


def _lin_op(e1, e2):
    a1, b1 = e1
    a2, b2 = e2
    return a1 * a2, a2 * b1 + b2


def s5_direction(u, lam_re, lam_im, log_dt, b_re, b_im, c_re, c_im):
    Bsz, L, G, H = u.shape
    lam = lax.complex(lam_re.astype(F32), lam_im.astype(F32))
    dt = jnp.exp(log_dt.astype(F32))[:, None]
    lam_bar = jnp.exp(lam * dt)
    b_bar = ((lam_bar - 1.0) / lam)[..., None] * lax.complex(b_re.astype(F32), b_im.astype(F32))
    c = lax.complex(c_re.astype(F32), c_im.astype(F32))
    n_chunks = L // S5_CHUNK
    uc = u.reshape(Bsz, n_chunks, S5_CHUNK, G, H).transpose(1, 0, 2, 3, 4)

    def chunk_step(state, u_chunk):
        bu = jnp.einsum('bcgh,gph->bcgp', u_chunk.astype(jnp.complex64), b_bar)
        a = jnp.broadcast_to(lam_bar, bu.shape)
        a_cum, s = lax.associative_scan(_lin_op, (a, bu), axis=1)
        s = s + a_cum * state[:, None]
        y = jnp.einsum('bcgp,ghp->bcgh', s, c).real
        return s[:, -1], y

    state0 = jnp.zeros((Bsz, G, S5_STATE), jnp.complex64)
    _, ys = lax.scan(chunk_step, state0, uc)
    return ys.transpose(1, 0, 2, 3, 4).reshape(Bsz, L, G, H)


def diff_attention(q, k, v, q_g, k_g, lq1, lk1, lq2, lk2, sub_g, lambda_init):
    Bsz, L = q.shape[0], q.shape[1]
    q = rope(rmsnorm(q.reshape(Bsz, L, 2 * DIFF_HEADS, DIFF_DH), q_g))
    k = rope(rmsnorm(k.reshape(Bsz, L, 2 * DIFF_HEADS, DIFF_DH), k_g))
    v = v.reshape(Bsz, L, DIFF_HEADS, 2 * DIFF_DH)
    lam = (jnp.exp(jnp.sum(lq1.astype(F32) * lk1.astype(F32)))
           - jnp.exp(jnp.sum(lq2.astype(F32) * lk2.astype(F32))) + lambda_init)
    scale = DIFF_DH ** -0.5
    qb = q.reshape(Bsz, L // Q_BLOCK, Q_BLOCK, 2 * DIFF_HEADS, DIFF_DH).transpose(1, 0, 2, 3, 4)

    def block(q_blk):
        s = jnp.einsum('bqhd,bkhd->bhqk', q_blk, k, preferred_element_type=F32) * scale
        p = jax.nn.softmax(s, axis=-1).reshape(Bsz, DIFF_HEADS, 2, Q_BLOCK, L)
        a = p[:, :, 0] - lam * p[:, :, 1]
        return jnp.einsum('bhqk,bkhe->bqhe', a.astype(v.dtype), v)

    o = lax.map(block, qb)
    o = o.transpose(1, 0, 2, 3, 4).reshape(Bsz, L, DIFF_HEADS, 2 * DIFF_DH)
    o = rmsnorm(o, sub_g) * (1.0 - lambda_init)
    return o.reshape(Bsz, L, DIFF_WIDTH)


def memory_attention(q, mem_n, w_kv, q_g, k_g):
    Bsz, L = q.shape[0], q.shape[1]
    M = mem_n.shape[1]
    kv = mem_n @ w_kv
    k, v = jnp.split(kv, 2, axis=-1)
    q = rmsnorm(q.reshape(Bsz, L, MEM_HEADS, MEM_DH), q_g)
    k = rmsnorm(k.reshape(Bsz, M, MEM_HEADS, MEM_DH), k_g)
    v = v.reshape(Bsz, M, MEM_HEADS, MEM_DH)
    s = jnp.einsum('bqhd,bmhd->bhqm', q, k, preferred_element_type=F32) * (MEM_DH ** -0.5)
    p = jax.nn.softmax(s, axis=-1)
    o = jnp.einsum('bhqm,bmhe->bqhe', p.astype(v.dtype), v)
    return o.reshape(Bsz, L, MEM_WIDTH)


def layer(x, mem, li, norm_mix_g, w_in, b_gate,
          s5_lam_re, s5_lam_im, s5_log_dt, s5_b_re, s5_b_im, s5_c_re, s5_c_im, s5_d, s5_w_glu,
          diff_q_g, diff_k_g, diff_lq1, diff_lk1, diff_lq2, diff_lk2, diff_sub_g,
          mem_norm_g, w_mem_kv, mem_q_g, mem_k_g,
          w_branch, w_out, ffn_norm_g, w_gate_up, w_down):
    Bsz, L, _ = x.shape
    h = rmsnorm(x, norm_mix_g[li])
    proj = h @ w_in[li]
    u, q, k, v, qm, gl = jnp.split(proj, SPLITS, axis=-1)

    uf = u.astype(F32)
    ug = uf.reshape(Bsz, L, S5_GROUPS, S5_GROUP)
    y_f = s5_direction(ug, s5_lam_re[li, 0], s5_lam_im[li, 0], s5_log_dt[li, 0],
                       s5_b_re[li, 0], s5_b_im[li, 0], s5_c_re[li, 0], s5_c_im[li, 0])
    y_b = jnp.flip(s5_direction(jnp.flip(ug, axis=1), s5_lam_re[li, 1], s5_lam_im[li, 1], s5_log_dt[li, 1],
                                s5_b_re[li, 1], s5_b_im[li, 1], s5_c_re[li, 1], s5_c_im[li, 1]), axis=1)
    y = (y_f + y_b).reshape(Bsz, L, S5_WIDTH) + s5_d[li].astype(F32) * uf
    z = jax.nn.gelu(y)
    s5_out = (z * jax.nn.sigmoid(z @ s5_w_glu[li].astype(F32))).astype(x.dtype)

    lambda_init = 0.8 - 0.6 * math.exp(-0.3 * li)
    diff_out = diff_attention(q, k, v, diff_q_g[li], diff_k_g[li], diff_lq1[li], diff_lk1[li],
                              diff_lq2[li], diff_lk2[li], diff_sub_g[li], lambda_init)

    mem_out = memory_attention(qm, rmsnorm(mem, mem_norm_g[li]), w_mem_kv[li], mem_q_g[li], mem_k_g[li])

    branches = jnp.stack([s5_out, diff_out.astype(x.dtype), mem_out.astype(x.dtype)], axis=2)
    br = jnp.einsum('blnc,ncd->blnd', branches, w_branch[li])
    gates = jax.nn.sigmoid((gl + b_gate[li]).astype(F32)).reshape(Bsz, L, N_BRANCH, D_MODEL)
    merged = jnp.sum(gates * br.astype(F32), axis=2).astype(x.dtype)
    x = x + merged @ w_out[li]

    h2 = rmsnorm(x, ffn_norm_g[li])
    g, up = jnp.split(h2 @ w_gate_up[li], 2, axis=-1)
    x = x + (jax.nn.silu(g) * up) @ w_down[li]
    return x


def setup_inputs(seed: int = 0) -> dict:
    key = jax.random.key(seed)
    ks = jax.random.split(key, 40)
    nrm = lambda k, shape, s: jax.random.normal(k, shape, F32) * s
    gain = lambda k, shape: 1.0 + 0.02 * jax.random.normal(k, shape, F32)
    G, P, H = S5_GROUPS, S5_STATE, S5_GROUP
    n_idx = jnp.arange(P, dtype=F32)
    lam_re = -0.5 + 0.01 * jax.random.normal(ks[5], (DEPTH, 2, G, P), F32)
    lam_im = math.pi * n_idx + 0.01 * jax.random.normal(ks[6], (DEPTH, 2, G, P), F32)
    log_dt = jax.random.uniform(ks[7], (DEPTH, 2, G), F32, math.log(DT_MIN), math.log(DT_MAX))
    return {
        "x_prompt": nrm(ks[0], (BATCH, SEQ, D_MODEL), 1.0),
        "x_sample": nrm(ks[1], (DEC_BATCH, DEC_SEQ, D_MODEL), 1.0),
        "mem_prompt": nrm(ks[2], (BATCH, N_MEM, D_MODEL), 1.0),
        "mem_sample": nrm(ks[3], (DEC_BATCH, N_MEM, D_MODEL), 1.0),
        "norm_mix_g": gain(ks[4], (DEPTH, D_MODEL)),
        "w_in": nrm(ks[8], (DEPTH, D_MODEL, IN_COLS), D_MODEL ** -0.5),
        "b_gate": nrm(ks[9], (DEPTH, N_BRANCH * D_MODEL), 0.02),
        "s5_lam_re": lam_re,
        "s5_lam_im": lam_im,
        "s5_log_dt": log_dt,
        "s5_b_re": nrm(ks[10], (DEPTH, 2, G, P, H), (2 * H) ** -0.5),
        "s5_b_im": nrm(ks[11], (DEPTH, 2, G, P, H), (2 * H) ** -0.5),
        "s5_c_re": nrm(ks[12], (DEPTH, 2, G, H, P), (2 * P) ** -0.5),
        "s5_c_im": nrm(ks[13], (DEPTH, 2, G, H, P), (2 * P) ** -0.5),
        "s5_d": nrm(ks[14], (DEPTH, S5_WIDTH), 1.0),
        "s5_w_glu": nrm(ks[15], (DEPTH, S5_WIDTH, S5_WIDTH), S5_WIDTH ** -0.5),
        "diff_q_g": gain(ks[16], (DEPTH, DIFF_DH)),
        "diff_k_g": gain(ks[17], (DEPTH, DIFF_DH)),
        "diff_lq1": nrm(ks[18], (DEPTH, DIFF_DH), 0.1),
        "diff_lk1": nrm(ks[19], (DEPTH, DIFF_DH), 0.1),
        "diff_lq2": nrm(ks[20], (DEPTH, DIFF_DH), 0.1),
        "diff_lk2": nrm(ks[21], (DEPTH, DIFF_DH), 0.1),
        "diff_sub_g": gain(ks[22], (DEPTH, 2 * DIFF_DH)),
        "mem_norm_g": gain(ks[23], (DEPTH, D_MODEL)),
        "w_mem_kv": nrm(ks[24], (DEPTH, D_MODEL, 2 * MEM_WIDTH), D_MODEL ** -0.5),
        "mem_q_g": gain(ks[25], (DEPTH, MEM_DH)),
        "mem_k_g": gain(ks[26], (DEPTH, MEM_DH)),
        "w_branch": nrm(ks[27], (DEPTH, N_BRANCH, D_MODEL, D_MODEL), D_MODEL ** -0.5),
        "w_out": nrm(ks[28], (DEPTH, D_MODEL, D_MODEL), D_MODEL ** -0.5),
        "ffn_norm_g": gain(ks[29], (DEPTH, D_MODEL)),
        "w_gate_up": nrm(ks[30], (DEPTH, D_MODEL, 2 * D_FF), D_MODEL ** -0.5),
        "w_down": nrm(ks[31], (DEPTH, D_FF, D_MODEL), D_FF ** -0.5),
    }


def reference(x_prompt, x_sample, mem_prompt, mem_sample, norm_mix_g, w_in, b_gate,
              s5_lam_re, s5_lam_im, s5_log_dt, s5_b_re, s5_b_im, s5_c_re, s5_c_im, s5_d, s5_w_glu,
              diff_q_g, diff_k_g, diff_lq1, diff_lk1, diff_lq2, diff_lk2, diff_sub_g,
              mem_norm_g, w_mem_kv, mem_q_g, mem_k_g,
              w_branch, w_out, ffn_norm_g, w_gate_up, w_down):
    y_prompt = x_prompt
    y_sample = x_sample
    for li in range(DEPTH):
        y_prompt = layer(y_prompt, mem_prompt, li, norm_mix_g, w_in, b_gate,
                         s5_lam_re, s5_lam_im, s5_log_dt, s5_b_re, s5_b_im, s5_c_re, s5_c_im, s5_d, s5_w_glu,
                         diff_q_g, diff_k_g, diff_lq1, diff_lk1, diff_lq2, diff_lk2, diff_sub_g,
                         mem_norm_g, w_mem_kv, mem_q_g, mem_k_g,
                         w_branch, w_out, ffn_norm_g, w_gate_up, w_down)
        y_sample = layer(y_sample, mem_sample, li, norm_mix_g, w_in, b_gate,
                         s5_lam_re, s5_lam_im, s5_log_dt, s5_b_re, s5_b_im, s5_c_re, s5_c_im, s5_d, s5_w_glu,
                         diff_q_g, diff_k_g, diff_lq1, diff_lk1, diff_lq2, diff_lk2, diff_sub_g,
                         mem_norm_g, w_mem_kv, mem_q_g, mem_k_g,
                         w_branch, w_out, ffn_norm_g, w_gate_up, w_down)
    return (y_prompt, y_sample)
```

```cpp
#include <hip/hip_runtime.h>
#include <hip/hip_cooperative_groups.h>
#include <cstdio>
#include <cstdint>
namespace cg = cooperative_groups;
#ifndef ATT_PIPE
#define ATT_PIPE 2
#endif
#ifndef GEMM_PF
#define GEMM_PF 3
#endif

typedef unsigned short bf16_t;
typedef short bf16x8 __attribute__((ext_vector_type(8)));
typedef float f32x4 __attribute__((ext_vector_type(4)));
typedef unsigned u32x4 __attribute__((ext_vector_type(4)));

constexpr int DM = 1024;
constexpr int TP = 16 * 2048, TS = 16 * 4096, TT = TP + TS;
constexpr int NCH = TT / 32;
constexpr int DFF = 2816;
constexpr float EPS = 1e-6f;
constexpr size_t MiB = 1024ull * 1024ull;
constexpr int MT = 4, BM = 32 * MT, WM = 16 * MT;
constexpr int LDS_BYTES = 81920;

constexpr size_t OFF_WT_IN = 0, OFF_WT_GLU = 16 * MiB, OFF_WT_MKV = 18 * MiB, OFF_WT_BR = 22 * MiB, OFF_WT_OUT = 28 * MiB,
                 OFF_WT_GU = 30 * MiB, OFF_WT_DN = 41 * MiB, OFF_ROPE = 46 * MiB + 512 * 1024, OFF_SSQK = 47 * MiB + 512 * 1024,
                 OFF_MEMN = 48 * MiB, OFF_MEMK = 64 * MiB, OFF_MEMVT = 80 * MiB, OFF_H = 96 * MiB, OFF_U = 288 * MiB, OFF_Q = 480 * MiB,
                 OFF_K = 672 * MiB, OFF_MA = 864 * MiB, OFF_MTC = 880 * MiB, OFF_CAR = 928 * MiB, OFF_END = 1024 * MiB;
constexpr size_t OFF_KC = OFF_CAR;
constexpr size_t OFF_Z = OFF_H;
constexpr size_t OFF_S5OUT = OFF_U;
constexpr size_t OFF_MERGED = OFF_K;
constexpr size_t OFF_ACT = OFF_H;
constexpr size_t OFF_H2 = OFF_K;
constexpr size_t DOFF_QM = 0, DOFF_VT = 192 * MiB;

struct Params {
    const float* x_p; const float* x_s; const float* mem_p; const float* mem_s;
    const float* norm_mix_g; const float* w_in; const float* b_gate;
    const float* lam_re; const float* lam_im; const float* log_dt; const float* b_re; const float* b_im; const float* c_re; const float* c_im;
    const float* s5_d; const float* w_glu;
    const float* q_g; const float* k_g; const float* lq1; const float* lk1; const float* lq2; const float* lk2; const float* sub_g;
    const float* mem_norm_g; const float* w_mkv; const float* mem_q_g; const float* mem_k_g;
    const float* w_branch; const float* w_out; const float* ffn_norm_g; const float* w_gu; const float* w_dn;
    float* out; char* ws;
};

typedef __bf16 bf16v2_t __attribute__((ext_vector_type(2)));
typedef float f32v2_t __attribute__((ext_vector_type(2)));
__device__ __forceinline__ unsigned pk2(float lo, float hi) { f32v2_t v = {lo, hi}; bf16v2_t b = __builtin_convertvector(v, bf16v2_t); return __builtin_bit_cast(unsigned, b); }
__device__ __forceinline__ float bf2f(unsigned short v) { return __uint_as_float(((unsigned)v) << 16); }
__device__ __forceinline__ float bflo(unsigned v) { return __uint_as_float(v << 16); }
__device__ __forceinline__ float bfhi(unsigned v) { return __uint_as_float(v & 0xffff0000u); }
__device__ __forceinline__ void st4bf(bf16_t* p, float a, float b, float c, float d) { uint2 v; v.x = pk2(a, b); v.y = pk2(c, d); *(uint2*)p = v; }
__device__ __forceinline__ float sigmoidf_(float x) { return 1.f / (1.f + __expf(-x)); }
__device__ __forceinline__ float gelu_tanh(float y) { float a = 0.7978845608028654f * (y + 0.044715f * y * y * y); float e = __expf(2.f * a); float t = 1.f - 2.f / (e + 1.f); return 0.5f * y * (1.f + t); }
__device__ __forceinline__ void seq_info(int t, int& s0, int& L) { if (t < TP) { L = 2048; s0 = t & ~2047; } else { L = 4096; s0 = TP + ((t - TP) & ~4095); } }
__device__ __forceinline__ int opaque_tid() { int t = threadIdx.x; asm volatile("" : "+v"(t)); return t; }
#define PHASE_IDS const int tid = opaque_tid(), lane = tid & 63, w = tid >> 6, wr = w >> 1, wc = w & 1, lr = lane & 15, lg = lane >> 4; (void)wr; (void)wc; (void)lr; (void)lg; (void)w; (void)lane;
#define MFMA16(a, b, c) __builtin_amdgcn_mfma_f32_16x16x32_bf16((a), (b), (c), 0, 0, 0)

struct APlain { const bf16_t* A; int lda; __device__ __forceinline__ const bf16_t* operator()(int row, int k) const { return A + (size_t)row * lda + k; } };
struct AS5 { const bf16_t* U; const bf16_t* CAR; int g;
    __device__ __forceinline__ const bf16_t* operator()(int chunk, int k) const {
        return k < 512 ? U + ((size_t)g * NCH + chunk) * 512 + k : CAR + ((size_t)g * NCH + chunk) * 256 + (k - 512); } };

template <int NT, bool SWAP, int PF, class AF>
__device__ __forceinline__ void gemm_main_pf(f32x4 (&acc)[MT][NT], const AF& af, int row0, const bf16_t* __restrict__ Bt, int ldb, int n0, int K, char* lds) {
    const int tid = opaque_tid(), lane = tid & 63, w = tid >> 6, wr = w >> 1, wc = w & 1, lr = lane & 15, lg = lane >> 4;
    constexpr int NB = NT;
    constexpr int AB = BM * 128, STG = (BM + NT * 32) * 128;
    const int ldr = tid >> 3, ldc = tid & 7;
    const int swz = ((ldc ^ (ldr & 7)) << 4);
    u32x4 ra0[MT], rb0[NB], ra1[MT], rb1[NB];
    const int nk = K >> 6;
#define GM_GLOAD(RA, RB, KT) { const int k_ = (KT) * 64 + ldc * 8; _Pragma("unroll") for (int i = 0; i < MT; ++i) RA[i] = *(const u32x4*)af(row0 + ldr + 32 * i, k_); \
                       _Pragma("unroll") for (int i = 0; i < NB; ++i) RB[i] = *(const u32x4*)(Bt + (size_t)(n0 + ldr + 32 * i) * ldb + k_); }
#define GM_LSTORE(RA, RB, ST_) { char* base_ = lds + (ST_) * STG; _Pragma("unroll") for (int i = 0; i < MT; ++i) *(u32x4*)(base_ + (ldr + 32 * i) * 128 + swz) = RA[i]; \
                       _Pragma("unroll") for (int i = 0; i < NB; ++i) *(u32x4*)(base_ + AB + (ldr + 32 * i) * 128 + swz) = RB[i]; }
#define GM_COMPUTE(ST_) { const char* base = lds + (ST_) * STG; \
        _Pragma("unroll") for (int kk = 0; kk < 2; ++kk) { \
            bf16x8 fa[MT], fb[NT]; \
            const int co = (((kk * 4 + lg) ^ (lr & 7)) << 4); \
            _Pragma("unroll") for (int m = 0; m < MT; ++m) fa[m] = *(const bf16x8*)(base + (wr * WM + m * 16 + lr) * 128 + co); \
            _Pragma("unroll") for (int n = 0; n < NT; ++n) fb[n] = *(const bf16x8*)(base + AB + (wc * (NT * 16) + n * 16 + lr) * 128 + co); \
            _Pragma("unroll") for (int m = 0; m < MT; ++m) _Pragma("unroll") for (int n = 0; n < NT; ++n) acc[m][n] = SWAP ? MFMA16(fb[n], fa[m], acc[m][n]) : MFMA16(fa[m], fb[n], acc[m][n]); } }
    if constexpr (PF == 2) {
    GM_GLOAD(ra0, rb0, 0); GM_LSTORE(ra0, rb0, 0); GM_GLOAD(ra1, rb1, 1); __syncthreads();
    for (int kt = 0; kt < nk; kt += 2) {
        { const int k2 = kt + 2 < nk ? kt + 2 : nk - 1; GM_GLOAD(ra0, rb0, k2); }
        GM_COMPUTE(0);
        GM_LSTORE(ra1, rb1, 1);
        __syncthreads();
        { const int k3 = kt + 3 < nk ? kt + 3 : nk - 1; GM_GLOAD(ra1, rb1, k3); }
        GM_COMPUTE(1);
        if (kt + 2 < nk) GM_LSTORE(ra0, rb0, 0);
        __syncthreads();
    }
    } else if constexpr (PF == 3) {
    u32x4 ra2[MT], rb2[NB];
    GM_GLOAD(ra0, rb0, 0); GM_LSTORE(ra0, rb0, 0); GM_GLOAD(ra1, rb1, 1); { const int k2 = 2 < nk ? 2 : nk - 1; GM_GLOAD(ra2, rb2, k2); } __syncthreads();
#define GM_STEP(KT, RL_A, RL_B, RS_A, RS_B) { const int kt_ = (KT); \
        { const int k3 = kt_ + 3 < nk ? kt_ + 3 : nk - 1; GM_GLOAD(RL_A, RL_B, k3); } \
        GM_COMPUTE(kt_ & 1); \
        if (kt_ + 1 < nk) GM_LSTORE(RS_A, RS_B, (kt_ + 1) & 1); \
        __syncthreads(); }
    for (int kt = 0; kt < nk; kt += 3) {
        GM_STEP(kt, ra0, rb0, ra1, rb1);
        if (kt + 1 >= nk) break;
        GM_STEP(kt + 1, ra1, rb1, ra2, rb2);
        if (kt + 2 >= nk) break;
        GM_STEP(kt + 2, ra2, rb2, ra0, rb0);
    }
    } else {
    GM_GLOAD(ra0, rb0, 0); GM_LSTORE(ra0, rb0, 0); __syncthreads();
    for (int kt = 0; kt < nk; kt += 2) {
        GM_GLOAD(ra0, rb0, kt + 1);
        GM_COMPUTE(0);
        GM_LSTORE(ra0, rb0, 1);
        __syncthreads();
        { const int k2 = kt + 2 < nk ? kt + 2 : nk - 1; GM_GLOAD(ra0, rb0, k2); }
        GM_COMPUTE(1);
        if (kt + 2 < nk) GM_LSTORE(ra0, rb0, 0);
        __syncthreads();
    }
    }
}
template <int NT, bool SWAP, class AF>
__device__ __forceinline__ void gemm_main(f32x4 (&acc)[MT][NT], const AF& af, int row0, const bf16_t* __restrict__ Bt, int ldb, int n0, int K, char* lds) {
    gemm_main_pf<NT, SWAP, (NT == 4 ? GEMM_PF : 2)>(acc, af, row0, Bt, ldb, n0, K, lds);
}
template <int NT> __device__ __forceinline__ void zero_acc(f32x4 (&acc)[MT][NT]) {
#pragma unroll
    for (int m = 0; m < MT; ++m)
#pragma unroll
        for (int n = 0; n < NT; ++n) acc[m][n] = (f32x4){0.f, 0.f, 0.f, 0.f};
}

__device__ __forceinline__ void wait_vm6() { asm volatile("s_waitcnt vmcnt(6)" ::: "memory"); }
__device__ __forceinline__ void wait_vm0() { asm volatile("s_waitcnt vmcnt(0)" ::: "memory"); }
template <int DH> __device__ __forceinline__ int kswz(int row, int c) { return DH == 64 ? row * 128 + ((c ^ (row & 7)) << 4) : row * 512 + ((c ^ (row & 15)) << 4); }
template <int DH, int E, int MQ, bool KSC, bool DB>
__device__ __forceinline__ void attn_pass(f32x4 (&O)[MQ][E / 16], const bf16x8 (&Qf)[MQ][DH / 32], const bf16_t* __restrict__ Kp, int ldk,
                                          const bf16_t* __restrict__ Vt, int ldv, int nkeys, const float* __restrict__ ksq, float bnd, char* lds) {
    constexpr int KB = 64 * DH * 2, VB = E * 128, ST = KB + VB, KC = DH / 8, NKL = 64 * KC / 256, NVL = E * 8 / 256;
    const int tid = opaque_tid(), lane = tid & 63, lr = lane & 15, lg = lane >> 4;
    float lsum[MQ];
#pragma unroll
    for (int q = 0; q < MQ; ++q) { lsum[q] = 0.f;
#pragma unroll
        for (int n = 0; n < E / 16; ++n) O[q][n] = (f32x4){0.f, 0.f, 0.f, 0.f}; }
    u32x4 rk[NKL], rv[NVL];
#define GLOADK(T) { const int key0_ = (T) * 64; _Pragma("unroll") for (int i = 0; i < NKL; ++i) { const int q = tid + 256 * i, r = q / KC, c = q % KC; rk[i] = *(const u32x4*)(Kp + (size_t)(key0_ + r) * ldk + c * 8); } }
#define GLOADV(T) { const int key0_ = (T) * 64; _Pragma("unroll") for (int i = 0; i < NVL; ++i) { const int q = tid + 256 * i, e = q >> 3, c = q & 7; rv[i] = *(const u32x4*)(Vt + (size_t)e * ldv + key0_ + c * 8); } }
#define LSTOREK(STG) { char* base_ = lds + (STG) * ST; _Pragma("unroll") for (int i = 0; i < NKL; ++i) { const int q = tid + 256 * i, r = q / KC, c = q % KC; *(u32x4*)(base_ + kswz<DH>(r, c)) = rk[i]; } }
#define LSTOREV(STG) { char* base_ = lds + (STG) * ST; _Pragma("unroll") for (int i = 0; i < NVL; ++i) { const int q = tid + 256 * i, e = q >> 3, c = q & 7; *(u32x4*)(base_ + KB + e * 128 + ((c ^ ((e >> 1) & 7)) << 4)) = rv[i]; } }
#define ATT_QK(S_, BASE_, SINIT_) { \
        _Pragma("unroll") for (int q = 0; q < MQ; ++q) _Pragma("unroll") for (int k4 = 0; k4 < 4; ++k4) S_[q][k4] = (f32x4){SINIT_, SINIT_, SINIT_, SINIT_}; \
        _Pragma("unroll") for (int k4 = 0; k4 < 4; ++k4) _Pragma("unroll") for (int kk = 0; kk < DH / 32; ++kk) { \
            const bf16x8 kf = *(const bf16x8*)((BASE_) + kswz<DH>(k4 * 16 + lr, kk * 4 + lg)); \
            _Pragma("unroll") for (int q = 0; q < MQ; ++q) S_[q][k4] = MFMA16(kf, Qf[q][kk], S_[q][k4]); } }
#define ATT_SOFTMAX(S_) { \
        _Pragma("unroll") for (int q = 0; q < MQ; ++q) { float ps = 0.f; \
            _Pragma("unroll") for (int k4 = 0; k4 < 4; ++k4) _Pragma("unroll") for (int j = 0; j < 4; ++j) { const float pv = __builtin_amdgcn_exp2f(S_[q][k4][j]); S_[q][k4][j] = pv; ps += pv; } \
            lsum[q] += ps; \
            _Pragma("unroll") for (int k2 = 0; k2 < 2; ++k2) { uint4 pw; pw.x = pk2(S_[q][2 * k2][0], S_[q][2 * k2][1]); pw.y = pk2(S_[q][2 * k2][2], S_[q][2 * k2][3]); \
                pw.z = pk2(S_[q][2 * k2 + 1][0], S_[q][2 * k2 + 1][1]); pw.w = pk2(S_[q][2 * k2 + 1][2], S_[q][2 * k2 + 1][3]); Pf[q][k2] = *(bf16x8*)&pw; } } }
#define ATT_PV(BASE_) { \
        _Pragma("unroll") for (int k2 = 0; k2 < 2; ++k2) _Pragma("unroll") for (int n = 0; n < E / 16; ++n) { \
            const char* rowp = (BASE_) + KB + n * 2048; \
            uint4 vw; const uint2 v0 = *(const uint2*)(rowp + (k2 == 0 ? vo00 : vo10)), v1 = *(const uint2*)(rowp + (k2 == 0 ? vo01 : vo11)); \
            vw.x = v0.x; vw.y = v0.y; vw.z = v1.x; vw.w = v1.y; const bf16x8 vf = *(bf16x8*)&vw; \
            _Pragma("unroll") for (int q = 0; q < MQ; ++q) O[q][n] = MFMA16(vf, Pf[q][k2], O[q][n]); } }
    const int vsw = (lr >> 1) & 7;
    const int vo00 = lr * 128 + (lg & 1) * 8 + ((((lg >> 1)) ^ vsw) << 4), vo01 = lr * 128 + (lg & 1) * 8 + ((((lg >> 1) + 2) ^ vsw) << 4);
    const int vo10 = lr * 128 + (lg & 1) * 8 + (((4 + (lg >> 1)) ^ vsw) << 4), vo11 = lr * 128 + (lg & 1) * 8 + (((6 + (lg >> 1)) ^ vsw) << 4);
    const int nt = nkeys >> 6;
    bf16x8 Pf[MQ][2];
#if ATT_PIPE == 2
    if (DB) {
        const float sinit = -bnd;
        f32x4 Sc[MQ][4];
#define ATT_ISSUE(T, STG) { const int key0_ = (T) * 64; char* sb_ = lds + (STG) * ST + tid * 16; \
        _Pragma("unroll") for (int i = 0; i < NKL; ++i) { const int L_ = tid + 256 * i, r = L_ / KC, c = (L_ % KC) ^ (r & 7); \
            __builtin_amdgcn_global_load_lds((const unsigned*)(Kp + (size_t)(key0_ + r) * ldk + c * 8), (__attribute__((address_space(3))) unsigned*)(sb_ + i * 4096), 16, 0, 0); } \
        _Pragma("unroll") for (int i = 0; i < NVL; ++i) { const int L_ = tid + 256 * i, e = L_ >> 3, c = (L_ & 7) ^ ((e >> 1) & 7); \
            __builtin_amdgcn_global_load_lds((const unsigned*)(Vt + (size_t)e * ldv + key0_ + c * 8), (__attribute__((address_space(3))) unsigned*)(sb_ + KB + i * 4096), 16, 0, 0); } }
        static_assert(!DB || (DH == 64 && NKL + NVL == 6), "glds attention path is written for DH = 64, E = 128");
        ATT_ISSUE(0, 0); ATT_ISSUE(1, 1);
        wait_vm6(); __builtin_amdgcn_s_barrier(); asm volatile("" ::: "memory");
        int st = 0;
        for (int t = 0; t < nt; ++t) {
            const int st2 = st == 0 ? 2 : st - 1;
            if (t + 2 < nt) ATT_ISSUE(t + 2, st2);
            ATT_QK(Sc, lds + st * ST, sinit);
            ATT_SOFTMAX(Sc);
            ATT_PV(lds + st * ST);
            if (t + 2 < nt) wait_vm6(); else wait_vm0();
            __builtin_amdgcn_s_barrier(); asm volatile("" ::: "memory");
            st = st == 2 ? 0 : st + 1;
        }
    } else
#elif !ATT_PIPE
    if (DB) {
        const float sinit = -bnd;
        f32x4 Sc[MQ][4];
        GLOADK(0); GLOADV(0); LSTOREK(0); LSTOREV(0); __syncthreads();
        for (int t = 0; t < nt; ++t) {
            { const int t1_ = t + 1 < nt ? t + 1 : nt - 1; GLOADK(t1_); GLOADV(t1_); }
            ATT_QK(Sc, lds + (t & 1) * ST, sinit);
            ATT_SOFTMAX(Sc);
            ATT_PV(lds + (t & 1) * ST);
            if (t + 1 < nt) { LSTOREK((t + 1) & 1); LSTOREV((t + 1) & 1); }
            __syncthreads();
        }
    } else
#endif
    if (DB) {
        const float sinit = -bnd;
        f32x4 Sc[MQ][4], Sn[MQ][4];
        GLOADK(0); GLOADV(0); LSTOREK(0); LSTOREV(0); __syncthreads();
        { const int t1_ = nt > 1 ? 1 : 0; GLOADK(t1_); GLOADV(t1_); }
        ATT_QK(Sc, lds, sinit);
        for (int t = 0; t < nt; ++t) {
            __syncthreads();
            if (t + 1 < nt) { LSTOREK((t + 1) & 1); LSTOREV((t + 1) & 1); }
            __syncthreads();
            { const int t2_ = t + 2 < nt ? t + 2 : nt - 1; GLOADK(t2_); GLOADV(t2_); }
            if (t + 1 < nt) ATT_QK(Sn, lds + ((t + 1) & 1) * ST, sinit);
            ATT_SOFTMAX(Sc);
            ATT_PV(lds + (t & 1) * ST);
#pragma unroll
            for (int q = 0; q < MQ; ++q)
#pragma unroll
                for (int k4 = 0; k4 < 4; ++k4) Sc[q][k4] = Sn[q][k4];
        }
        __syncthreads();
    } else {
        GLOADK(0); LSTOREK(0); GLOADV(0); LSTOREV(0); __syncthreads();
        for (int t = 0; t < nt; ++t) {
            f32x4 Sc[MQ][4];
            ATT_QK(Sc, lds, 0.f);
            if (KSC) {
#pragma unroll
                for (int k4 = 0; k4 < 4; ++k4) {
                    float4 sq = *(const float4*)(ksq + t * 64 + k4 * 16 + 4 * lg);
#pragma unroll
                    for (int pt = 1; pt < 4; ++pt) { const float4 s2 = *(const float4*)(ksq + pt * 8192 + t * 64 + k4 * 16 + 4 * lg); sq.x += s2.x; sq.y += s2.y; sq.z += s2.z; sq.w += s2.w; }
                    const float s0 = rsqrtf(sq.x * (1.f / 256.f) + EPS), s1 = rsqrtf(sq.y * (1.f / 256.f) + EPS), s2 = rsqrtf(sq.z * (1.f / 256.f) + EPS), s3 = rsqrtf(sq.w * (1.f / 256.f) + EPS);
#pragma unroll
                    for (int q = 0; q < MQ; ++q) { Sc[q][k4][0] = fmaf(Sc[q][k4][0], s0, -bnd); Sc[q][k4][1] = fmaf(Sc[q][k4][1], s1, -bnd); Sc[q][k4][2] = fmaf(Sc[q][k4][2], s2, -bnd); Sc[q][k4][3] = fmaf(Sc[q][k4][3], s3, -bnd); }
                }
            } else {
#pragma unroll
                for (int q = 0; q < MQ; ++q)
#pragma unroll
                    for (int k4 = 0; k4 < 4; ++k4) Sc[q][k4] -= bnd;
            }
            ATT_SOFTMAX(Sc);
            ATT_PV(lds);
            __syncthreads();
            if (t + 1 < nt) { GLOADK(t + 1); LSTOREK(0); GLOADV(t + 1); LSTOREV(0); __syncthreads(); }
        }
    }
#pragma unroll
    for (int q = 0; q < MQ; ++q) {
        float l = lsum[q]; l += __shfl_xor(l, 16); l += __shfl_xor(l, 32);
        const float inv = 1.f / l;
#pragma unroll
        for (int n = 0; n < E / 16; ++n) O[q][n] *= inv;
    }
}

__device__ __forceinline__ void rms_row(const float* __restrict__ src, const float* __restrict__ g, bf16_t* __restrict__ dst, int lane) {
    float4 v[4]; float ss = 0.f;
#pragma unroll
    for (int i = 0; i < 4; ++i) { v[i] = *(const float4*)(src + (i * 64 + lane) * 4); ss += v[i].x * v[i].x + v[i].y * v[i].y + v[i].z * v[i].z + v[i].w * v[i].w; }
#pragma unroll
    for (int o = 32; o > 0; o >>= 1) ss += __shfl_xor(ss, o);
    const float rstd = rsqrtf(ss * (1.f / 1024.f) + EPS);
#pragma unroll
    for (int i = 0; i < 4; ++i) { const float4 gg = *(const float4*)(g + (i * 64 + lane) * 4);
        st4bf(dst + (i * 64 + lane) * 4, v[i].x * rstd * gg.x, v[i].y * rstd * gg.y, v[i].z * rstd * gg.z, v[i].w * rstd * gg.w); }
}

template <bool PERM_GU>
__device__ __forceinline__ void transpose_w(const float* __restrict__ src, int K, int N, bf16_t* __restrict__ dst, char* lds) {
    float* T = (float*)lds;
    const int tid = opaque_tid(), tk = K / 64, tn = N / 64;
    for (int t = blockIdx.x; t < tk * tn; t += gridDim.x) {
        const int k0 = (t / tn) * 64, n0 = (t % tn) * 64;
#pragma unroll
        for (int i = 0; i < 16; ++i) { const int kr = (tid >> 6) + 4 * i, nc = tid & 63; T[kr * 65 + nc] = src[(size_t)(k0 + kr) * N + n0 + nc]; }
        __syncthreads();
        const int nl = tid >> 2, ks = (tid & 3) * 16;
        int n = n0 + nl;
        if (PERM_GU) { const int isup = n >= DFF ? 1 : 0; const int c = n - isup * DFF; n = (c >> 6) * 128 + ((c >> 5) & 1) * 64 + (((c >> 4) & 1) * 2 + isup) * 16 + (c & 15); }
        uint4 o0, o1;
        o0.x = pk2(T[(ks + 0) * 65 + nl], T[(ks + 1) * 65 + nl]); o0.y = pk2(T[(ks + 2) * 65 + nl], T[(ks + 3) * 65 + nl]);
        o0.z = pk2(T[(ks + 4) * 65 + nl], T[(ks + 5) * 65 + nl]); o0.w = pk2(T[(ks + 6) * 65 + nl], T[(ks + 7) * 65 + nl]);
        o1.x = pk2(T[(ks + 8) * 65 + nl], T[(ks + 9) * 65 + nl]); o1.y = pk2(T[(ks + 10) * 65 + nl], T[(ks + 11) * 65 + nl]);
        o1.z = pk2(T[(ks + 12) * 65 + nl], T[(ks + 13) * 65 + nl]); o1.w = pk2(T[(ks + 14) * 65 + nl], T[(ks + 15) * 65 + nl]);
        bf16_t* d = dst + (size_t)n * K + k0 + ks;
        *(uint4*)d = o0; *(uint4*)(d + 8) = o1;
        __syncthreads();
    }
}

__device__ __forceinline__ float2 cmul(float2 a, float2 b) { return make_float2(a.x * b.x - a.y * b.y, a.x * b.y + a.y * b.x); }
__device__ __forceinline__ void s5_prep(const Params& p, int g, int dir, char* lds) {
    float2* POW = (float2*)lds;
    float2* BB = POW + 33 * 64;
    float2* CC = BB + 64 * 16;
    float2* COEF = CC + 16 * 64;
    const int tid = opaque_tid();
    const int gd = dir * 64 + g;
    if (tid < 64) {
        const int pp = tid;
        const float lre = p.lam_re[gd * 64 + pp], lim = p.lam_im[gd * 64 + pp];
        const float dt = expf(p.log_dt[gd]);
        for (int d = 0; d <= 32; ++d) { const float mag = expf((float)d * lre * dt); float sn, cs; sincosf((float)d * lim * dt, &sn, &cs); POW[d * 64 + pp] = make_float2(mag * cs, mag * sn); }
        const float a = lre * dt, b = lim * dt; float sn, cs, sh, ch; sincosf(b, &sn, &cs); sincosf(0.5f * b, &sh, &ch);
        const float nr = expm1f(a) * cs - 2.f * sh * sh, ni = expf(a) * sn;
        const float den = 1.f / (lre * lre + lim * lim);
        COEF[pp] = make_float2((nr * lre + ni * lim) * den, (ni * lre - nr * lim) * den);
    }
    __syncthreads();
    for (int i = tid; i < 1024; i += 256) {
        const int pp = i >> 4, h = i & 15;
        BB[i] = cmul(COEF[pp], make_float2(p.b_re[(gd * 64 + pp) * 16 + h], p.b_im[(gd * 64 + pp) * 16 + h]));
        const int hh = i >> 6, p2 = i & 63;
        CC[i] = make_float2(p.c_re[(gd * 16 + hh) * 64 + p2], p.c_im[(gd * 16 + hh) * 64 + p2]);
    }
    __syncthreads();
    float* Kc = (float*)(p.ws + OFF_KC) + (size_t)(g * 2 + dir) * 32 * 256;
    { const int hp = tid >> 4, h = tid & 15;
      float sacc[32];
#pragma unroll
      for (int d = 0; d < 32; ++d) sacc[d] = 0.f;
#pragma unroll 1
      for (int pp = 0; pp < 64; ++pp) { const float2 wcb = cmul(CC[hp * 64 + pp], BB[pp * 16 + h]);
#pragma unroll
          for (int d = 0; d < 32; ++d) { const float2 pw = POW[d * 64 + pp]; sacc[d] += wcb.x * pw.x - wcb.y * pw.y; } }
#pragma unroll
      for (int d = 0; d < 32; ++d) Kc[d * 256 + tid] = sacc[d]; }
    bf16_t* MA = (bf16_t*)(p.ws + OFF_MA) + ((size_t)g * 256 + dir * 128) * 512;
    for (int i = tid; i < 128 * 512; i += 256) {
        const int k = i & 511, nl = i >> 9, pp = nl >> 1, c = nl & 1, j = k >> 4, h = k & 15;
        const float2 w = cmul(POW[(dir == 0 ? 31 - j : j) * 64 + pp], BB[pp * 16 + h]);
        const float v = c == 0 ? w.x : w.y;
        MA[(size_t)nl * 512 + k] = (bf16_t)(pk2(v, 0.f) & 0xffff);
    }
    bf16_t* MTC = (bf16_t*)(p.ws + OFF_MTC) + (size_t)g * 512 * 768 + 512 + dir * 128;
    for (int i = tid; i < 512 * 128; i += 256) {
        const int cl = i & 127, row = i >> 7, pp = cl >> 1, c = cl & 1, ii = row >> 4, hp = row & 15;
        const float2 w = cmul(CC[hp * 64 + pp], POW[(dir == 0 ? ii + 1 : 32 - ii) * 64 + pp]);
        const float v = c == 0 ? w.x : -w.y;
        MTC[(size_t)row * 768 + cl] = (bf16_t)(pk2(v, 0.f) & 0xffff);
    }
    __syncthreads();
}

#ifndef DIFF_MQ
#define DIFF_MQ 2
#endif
#ifndef MEM_MQ
#define MEM_MQ 1
#endif
#ifndef PM
#define PM 0xffff
#endif
#define GRID_SYNC() do { asm volatile("s_waitcnt vmcnt(0)" ::: "memory"); grid.sync(); } while (0)
__global__ void __launch_bounds__(256, 2) fwd_megakernel(Params p) {
    cg::grid_group grid = cg::this_grid();
    extern __shared__ __attribute__((aligned(16))) char smem[];
    const int nb = gridDim.x, bid = blockIdx.x;
    char* ws = p.ws;
    bf16_t* WT_IN = (bf16_t*)(ws + OFF_WT_IN); bf16_t* WT_GLU = (bf16_t*)(ws + OFF_WT_GLU); bf16_t* WT_MKV = (bf16_t*)(ws + OFF_WT_MKV);
    bf16_t* WT_BR = (bf16_t*)(ws + OFF_WT_BR); bf16_t* WT_OUT = (bf16_t*)(ws + OFF_WT_OUT); bf16_t* WT_GU = (bf16_t*)(ws + OFF_WT_GU); bf16_t* WT_DN = (bf16_t*)(ws + OFF_WT_DN);
    float* ROPE = (float*)(ws + OFF_ROPE); float* SSQK = (float*)(ws + OFF_SSQK);
    bf16_t* MEMN = (bf16_t*)(ws + OFF_MEMN); bf16_t* MEMK = (bf16_t*)(ws + OFF_MEMK); bf16_t* MEMVT = (bf16_t*)(ws + OFF_MEMVT);
    bf16_t* Hh = (bf16_t*)(ws + OFF_H); bf16_t* Ub = (bf16_t*)(ws + OFF_U); bf16_t* Qb = (bf16_t*)(ws + OFF_Q); bf16_t* Kb = (bf16_t*)(ws + OFF_K);
    bf16_t* MA = (bf16_t*)(ws + OFF_MA); bf16_t* MTC = (bf16_t*)(ws + OFF_MTC); bf16_t* CAR = (bf16_t*)(ws + OFF_CAR);
    bf16_t* Zb = (bf16_t*)(ws + OFF_Z); bf16_t* S5O = (bf16_t*)(ws + OFF_S5OUT); bf16_t* MRG = (bf16_t*)(ws + OFF_MERGED); bf16_t* ACT = (bf16_t*)(ws + OFF_ACT); bf16_t* H2 = (bf16_t*)(ws + OFF_H2);
    bf16_t* QM = (bf16_t*)((char*)p.out + DOFF_QM); bf16_t* VT = (bf16_t*)((char*)p.out + DOFF_VT); bf16_t* HR = VT;

    transpose_w<false>(p.w_in, 1024, 8192, WT_IN, smem);
    transpose_w<false>(p.w_glu, 1024, 1024, WT_GLU, smem);
    transpose_w<false>(p.w_mkv, 1024, 2048, WT_MKV, smem);
    for (int n3 = 0; n3 < 3; ++n3) transpose_w<false>(p.w_branch + (size_t)n3 * 1024 * 1024, 1024, 1024, WT_BR + (size_t)n3 * 1024 * 1024, smem);
    transpose_w<false>(p.w_out, 1024, 1024, WT_OUT, smem);
    transpose_w<true>(p.w_gu, 1024, 2 * DFF, WT_GU, smem);
    transpose_w<false>(p.w_dn, DFF, 1024, WT_DN, smem);
    for (int it = bid; it < TT / 4; it += nb) { PHASE_IDS const int t = it * 4 + w; const float* src = t < TP ? p.x_p + (size_t)t * DM : p.x_s + (size_t)(t - TP) * DM; rms_row(src, p.norm_mix_g, Hh + (size_t)t * DM, lane); }
    for (int it = bid; it < 8192 / 4; it += nb) { PHASE_IDS const int r = it * 4 + w; const float* src = r < 4096 ? p.mem_p + (size_t)r * DM : p.mem_s + (size_t)(r - 4096) * DM; rms_row(src, p.mem_norm_g, MEMN + (size_t)r * DM, lane); }
    for (int it = bid; it < 4096 * 32 / 256; it += nb) { PHASE_IDS const int i = it * 256 + tid, pos = i >> 5, d = i & 31;
        const float inv = powf(10000.f, -(float)d / 32.f); float sn, cs; sincosf((float)pos * inv, &sn, &cs); ROPE[pos * 64 + d] = cs; ROPE[pos * 64 + 32 + d] = sn; }
    if (PM & 4) for (int it = bid; it < 128; it += nb) s5_prep(p, it >> 1, it & 1, smem);
    GRID_SYNC();

    {
        const int n_in = (TT / BM) * 40, n_mkv = (8192 / BM) * 16, n_exp = 64 * 512 * 64 / 256;
        for (int it = bid; it < n_in + n_mkv + n_exp; it += nb) {
            PHASE_IDS
            if (it < n_in) {
                const int mt = it / 40, nt = it % 40, seg = nt >> 3, row0 = mt * BM, n0 = nt * 128;
                APlain af{Hh, DM};
                int s0, L; seq_info(row0, s0, L);
                if (seg == 3) {
                    f32x4 acc[MT][4]; zero_acc<4>(acc);
                    gemm_main<4, false>(acc, af, row0, WT_IN, DM, n0, DM, smem);
#pragma unroll
                    for (int m = 0; m < MT; ++m)
#pragma unroll
                        for (int n = 0; n < 4; ++n) { const int pos = row0 - s0 + wr * WM + m * 16 + 4 * lg, col = (nt & 7) * 128 + wc * 64 + n * 16 + lr;
                            st4bf(VT + (size_t)s0 * DM + (size_t)col * L + pos, acc[m][n][0], acc[m][n][1], acc[m][n][2], acc[m][n][3]); }
                } else {
                    f32x4 acc[MT][4]; zero_acc<4>(acc);
                    gemm_main<4, true>(acc, af, row0, WT_IN, DM, n0, DM, smem);
                    const int cb = (nt & 7) * 128 + wc * 64 + 4 * lg;
                    if (seg == 0) {
#pragma unroll
                        for (int m = 0; m < MT; ++m) { const int row = row0 + wr * WM + m * 16 + lr;
#pragma unroll
                            for (int n = 0; n < 4; ++n) { const int g = (nt & 7) * 8 + wc * 4 + n;
                                st4bf(Ub + ((size_t)g * NCH + (row >> 5)) * 512 + (row & 31) * 16 + 4 * lg, acc[m][n][0], acc[m][n][1], acc[m][n][2], acc[m][n][3]); } }
                    } else if (seg == 4) {
#pragma unroll
                        for (int m = 0; m < MT; ++m) { const int row = row0 + wr * WM + m * 16 + lr;
#pragma unroll
                            for (int n = 0; n < 4; ++n) st4bf(QM + (size_t)row * DM + cb + n * 16, acc[m][n][0], acc[m][n][1], acc[m][n][2], acc[m][n][3]); }
                    } else {
                        const float* gain = seg == 1 ? p.q_g : p.k_g; bf16_t* dst = seg == 1 ? Qb : Kb;
                        const float osc = seg == 1 ? 0.125f * 1.4426950408889634f : 1.f;
                        f32x4 gn[4];
#pragma unroll
                        for (int n = 0; n < 4; ++n) gn[n] = *(const f32x4*)(gain + n * 16 + 4 * lg);
#pragma unroll
                        for (int m = 0; m < MT; ++m) { const int row = row0 + wr * WM + m * 16 + lr, pos = row - s0;
                            float ss = 0.f;
#pragma unroll
                            for (int n = 0; n < 4; ++n)
#pragma unroll
                                for (int j = 0; j < 4; ++j) ss += acc[m][n][j] * acc[m][n][j];
                            ss += __shfl_xor(ss, 16); ss += __shfl_xor(ss, 32);
                            const float rstd = rsqrtf(ss * (1.f / 64.f) + EPS);
                            f32x4 o[4];
#pragma unroll
                            for (int n = 0; n < 2; ++n) { const f32x4 cs = *(const f32x4*)(ROPE + pos * 64 + n * 16 + 4 * lg), sn = *(const f32x4*)(ROPE + pos * 64 + 32 + n * 16 + 4 * lg);
#pragma unroll
                                for (int j = 0; j < 4; ++j) { const float x1 = acc[m][n][j] * rstd * gn[n][j], x2 = acc[m][n + 2][j] * rstd * gn[n + 2][j];
                                    o[n][j] = (x1 * cs[j] - x2 * sn[j]) * osc; o[n + 2][j] = (x1 * sn[j] + x2 * cs[j]) * osc; } }
#pragma unroll
                            for (int n = 0; n < 4; ++n) st4bf(dst + (size_t)row * DM + cb + n * 16, o[n][0], o[n][1], o[n][2], o[n][3]); }
                    }
                }
            } else if (it < n_in + n_mkv) {
                const int i2 = it - n_in, mt = i2 / 16, nt = i2 % 16, row0 = mt * BM, n0 = nt * 128;
                APlain af{MEMN, DM};
                if (nt < 8) {
                    f32x4 acc[MT][4]; zero_acc<4>(acc);
                    gemm_main<4, true>(acc, af, row0, WT_MKV, DM, n0, DM, smem);
                    const int cb = nt * 128 + wc * 64 + 4 * lg, head = nt >> 1;
#pragma unroll
                    for (int m = 0; m < MT; ++m) { const int row = row0 + wr * WM + m * 16 + lr; float ss = 0.f;
#pragma unroll
                        for (int n = 0; n < 4; ++n) { st4bf(MEMK + (size_t)row * DM + cb + n * 16, acc[m][n][0], acc[m][n][1], acc[m][n][2], acc[m][n][3]);
#pragma unroll
                            for (int j = 0; j < 4; ++j) ss += acc[m][n][j] * acc[m][n][j]; }
                        ss += __shfl_xor(ss, 16); ss += __shfl_xor(ss, 32);
                        if (lg == 0) SSQK[(head * 4 + (nt & 1) * 2 + wc) * 8192 + row] = ss; }
                } else {
                    f32x4 acc[MT][4]; zero_acc<4>(acc);
                    gemm_main<4, false>(acc, af, row0, WT_MKV, DM, n0, DM, smem);
#pragma unroll
                    for (int m = 0; m < MT; ++m)
#pragma unroll
                        for (int n = 0; n < 4; ++n) { const int row = row0 + wr * WM + m * 16 + 4 * lg, b = row >> 8, key = row & 255, col = (nt - 8) * 128 + wc * 64 + n * 16 + lr;
                            st4bf(MEMVT + ((size_t)b * 1024 + col) * 256 + key, acc[m][n][0], acc[m][n][1], acc[m][n][2], acc[m][n][3]); }
                }
            } else {
                const int i3 = (it - n_in - n_mkv) * 256 + tid;
                const int g = i3 >> 15, row = (i3 >> 6) & 511, kc = i3 & 63, ii = row >> 4, hp = row & 15, j = kc >> 1, h0 = (kc & 1) * 8;
                const float* Kc = (const float*)(ws + OFF_KC) + (size_t)g * 2 * 32 * 256;
                float v[8];
#pragma unroll
                for (int e = 0; e < 8; ++e) v[e] = 0.f;
                if (j <= ii) { const float* s = Kc + (ii - j) * 256 + hp * 16 + h0;
#pragma unroll
                    for (int e = 0; e < 8; ++e) v[e] += s[e]; }
                if (j >= ii) { const float* s = Kc + 32 * 256 + (j - ii) * 256 + hp * 16 + h0;
#pragma unroll
                    for (int e = 0; e < 8; ++e) v[e] += s[e]; }
                if (j == ii) {
#pragma unroll
                    for (int e = 0; e < 8; ++e) if (h0 + e == hp) v[e] += p.s5_d[g * 16 + hp]; }
                uint4 o; o.x = pk2(v[0], v[1]); o.y = pk2(v[2], v[3]); o.z = pk2(v[4], v[5]); o.w = pk2(v[6], v[7]);
                *(uint4*)(MTC + ((size_t)g * 512 + row) * 768 + j * 16 + h0) = o;
            }
        }
    }
    GRID_SYNC();

    for (int it = bid; it < 64 * (NCH / BM) * 2; it += nb) {
        PHASE_IDS
        int g = it / ((NCH / BM) * 2), r = it % ((NCH / BM) * 2);
        if ((nb & 7) == 0 && (64 * (NCH / BM) * 2) % nb == 0) {
            const int lu = (it / nb) * (nb >> 3) + (bid >> 3); g = (lu / ((NCH / BM) * 2)) * 8 + (bid & 7); r = lu % ((NCH / BM) * 2); }
        const int ct = r >> 1, nt = r & 1;
        AS5 af{Ub, CAR, g};
        f32x4 acc[MT][4]; zero_acc<4>(acc);
        gemm_main<4, true>(acc, af, ct * BM, MA + (size_t)g * 256 * 512, 512, nt * 128, 512, smem);
#pragma unroll
        for (int m = 0; m < MT; ++m) { const int chunk = ct * BM + wr * WM + m * 16 + lr;
#pragma unroll
            for (int n = 0; n < 4; ++n) st4bf(CAR + ((size_t)g * NCH + chunk) * 256 + nt * 128 + wc * 64 + n * 16 + 4 * lg, acc[m][n][0], acc[m][n][1], acc[m][n][2], acc[m][n][3]); }
    }
    GRID_SYNC();

    for (int it = bid; it < 32 * 64 * 128 / 256; it += nb) {
        PHASE_IDS
        const int i = it * 256 + tid, pd = i & 127, g = (i >> 7) & 63, b = i >> 13, dir = pd >> 6, pp = pd & 63;
        const int gd = dir * 64 + g;
        const float dt = expf(p.log_dt[gd]);
        const float lre = p.lam_re[gd * 64 + pp], lim = p.lam_im[gd * 64 + pp];
        const float mag = expf(32.f * lre * dt); float sn, cs; sincosf(32.f * lim * dt, &sn, &cs);
        const float ar = mag * cs, ai = mag * sn;
        const int c0 = b < 16 ? b * 64 : 1024 + (b - 16) * 128, nc = b < 16 ? 64 : 128;
        unsigned* base = (unsigned*)(CAR + ((size_t)g * NCH + c0) * 256 + pd * 2);
        float sr = 0.f, si = 0.f;
        for (int c8 = 0; c8 < nc; c8 += 8) {
            unsigned ev[8];
#pragma unroll
            for (int u = 0; u < 8; ++u) { const int cc = dir == 0 ? c8 + u : nc - 1 - (c8 + u); ev[u] = base[(size_t)cc * 128]; }
#pragma unroll
            for (int u = 0; u < 8; ++u) { const int cc = dir == 0 ? c8 + u : nc - 1 - (c8 + u);
                base[(size_t)cc * 128] = pk2(sr, si);
                const float er = bflo(ev[u]), ei = bfhi(ev[u]);
                const float nr = ar * sr - ai * si + er, ni = ar * si + ai * sr + ei;
                sr = nr; si = ni; }
        }
    }
    GRID_SYNC();

    {
        constexpr int DQ = 64 * DIFF_MQ, NQS = 4096 / DQ, NQP = 2048 / DQ;
        const int n_ds = 16 * 8 * NQS, n_dp = 16 * 8 * NQP, n_s5 = 64 * (NCH / BM) * 4, n_mem = (TT / (MEM_MQ * 64)) * 4;
        if (PM & 1) for (int it = bid; it < n_ds + n_dp; it += nb) {
            PHASE_IDS
            {
                int b, h, qt, L, s0;
                if ((nb & 7) == 0 && (n_ds + n_dp) % nb == 0) {
                    const int xcd = bid & 7, slot = bid >> 3, spx = nb >> 3, rnd = it / nb;
                    const int lu = rnd * spx + slot;
                    const int per_s = 16 * NQS;
                    if (lu < per_s) { L = 4096; const int bh = (lu / NQS) * 8 + xcd; qt = lu % NQS; b = bh >> 3; h = bh & 7; s0 = TP + b * 4096; }
                    else { const int l2 = lu - per_s; L = 2048; const int bh = (l2 / NQP) * 8 + xcd; qt = l2 % NQP; b = bh >> 3; h = bh & 7; s0 = b * 2048; }
                } else
                if (it < n_ds) { L = 4096; b = it / (8 * NQS); const int r = it % (8 * NQS); h = r / NQS; qt = r % NQS; s0 = TP + b * 4096; }
                else { const int i2 = it - n_ds; L = 2048; b = i2 / (8 * NQP); const int r = i2 % (8 * NQP); h = r / NQP; qt = r % NQP; s0 = b * 2048; }
                const int q0 = s0 + qt * DQ + w * (16 * DIFF_MQ);
                float bnd;
                { float gq = fabsf(p.q_g[lane]), gk = fabsf(p.k_g[lane]);
#pragma unroll
                  for (int o = 32; o > 0; o >>= 1) { gq = fmaxf(gq, __shfl_xor(gq, o)); gk = fmaxf(gk, __shfl_xor(gk, o)); }
                  bnd = fminf(64.f * gq * gk * (0.125f * 1.4426950408889634f), 60.f); }
                f32x4 O[DIFF_MQ][8];
                {
                    bf16x8 Qf[DIFF_MQ][2];
#pragma unroll
                    for (int mq = 0; mq < DIFF_MQ; ++mq)
#pragma unroll
                        for (int kk = 0; kk < 2; ++kk) Qf[mq][kk] = *(const bf16x8*)(Qb + (size_t)(q0 + mq * 16 + lr) * DM + (2 * h) * 64 + kk * 32 + lg * 8);
                    attn_pass<64, 128, DIFF_MQ, false, true>(O, Qf, Kb + (size_t)s0 * DM + (2 * h) * 64, DM, VT + (size_t)s0 * DM + (size_t)(h * 128) * L, L, L, nullptr, bnd, smem);
#pragma unroll
                    for (int mq = 0; mq < DIFF_MQ; ++mq)
#pragma unroll
                        for (int kk = 0; kk < 2; ++kk) Qf[mq][kk] = *(const bf16x8*)(Qb + (size_t)(q0 + mq * 16 + lr) * DM + (2 * h + 1) * 64 + kk * 32 + lg * 8);
                    asm volatile("s_waitcnt vmcnt(0)" ::: "memory");
#pragma unroll
                    for (int mq = 0; mq < DIFF_MQ; ++mq)
#pragma unroll
                        for (int n = 0; n < 8; ++n) { uint2 v; v.x = pk2(O[mq][n][0], O[mq][n][1]); v.y = pk2(O[mq][n][2], O[mq][n][3]);
#if ATT_PIPE == 2
                            *(uint2*)(Qb + (size_t)(q0 + mq * 16 + lr) * DM + h * 128 + n * 16 + 4 * lg) = v; }
#else
                            *(uint2*)(smem + 49152 + ((w * DIFF_MQ + mq) * 8 + n) * 512 + lane * 8) = v; }
#endif
                    __syncthreads();
                    attn_pass<64, 128, DIFF_MQ, false, true>(O, Qf, Kb + (size_t)s0 * DM + (2 * h + 1) * 64, DM, VT + (size_t)s0 * DM + (size_t)(h * 128) * L, L, L, nullptr, bnd, smem);
                }
                float d1 = p.lq1[lane] * p.lk1[lane], d2 = p.lq2[lane] * p.lk2[lane];
#pragma unroll
                for (int o = 32; o > 0; o >>= 1) { d1 += __shfl_xor(d1, o); d2 += __shfl_xor(d2, o); }
                const float lam = expf(d1) - expf(d2) + 0.2f;
#pragma unroll
                for (int mq = 0; mq < DIFF_MQ; ++mq) {
                    float ss = 0.f;
#pragma unroll
                    for (int n = 0; n < 8; ++n) {
#if ATT_PIPE == 2
                        uint2 o1; { const unsigned long long ov = __hip_atomic_load((const unsigned long long*)(Qb + (size_t)(q0 + mq * 16 + lr) * DM + h * 128 + n * 16 + 4 * lg), __ATOMIC_RELAXED, __HIP_MEMORY_SCOPE_AGENT); o1.x = (unsigned)ov; o1.y = (unsigned)(ov >> 32); }
#else
                        const uint2 o1 = *(const uint2*)(smem + 49152 + ((w * DIFF_MQ + mq) * 8 + n) * 512 + lane * 8);
#endif
                        O[mq][n][0] = bflo(o1.x) - lam * O[mq][n][0]; O[mq][n][1] = bfhi(o1.x) - lam * O[mq][n][1];
                        O[mq][n][2] = bflo(o1.y) - lam * O[mq][n][2]; O[mq][n][3] = bfhi(o1.y) - lam * O[mq][n][3];
#pragma unroll
                        for (int j = 0; j < 4; ++j) ss += O[mq][n][j] * O[mq][n][j];
                    }
                    ss += __shfl_xor(ss, 16); ss += __shfl_xor(ss, 32);
                    const float sc = rsqrtf(ss * (1.f / 128.f) + EPS) * 0.8f;
                    bf16_t* dst = Qb + (size_t)(q0 + mq * 16 + lr) * DM + h * 128 + 4 * lg;
#pragma unroll
                    for (int n = 0; n < 8; ++n) { const f32x4 sg = *(const f32x4*)(p.sub_g + n * 16 + 4 * lg);
                        st4bf(dst + n * 16, O[mq][n][0] * sc * sg[0], O[mq][n][1] * sc * sg[1], O[mq][n][2] * sc * sg[2], O[mq][n][3] * sc * sg[3]); }
                }
            }
        }
        for (int it = bid; it < n_s5; it += nb) {
            PHASE_IDS
            {
                int g = it / ((NCH / BM) * 4), r = it % ((NCH / BM) * 4);
                if ((nb & 7) == 0 && n_s5 % nb == 0) {
                    const int lu = (it / nb) * (nb >> 3) + (bid >> 3); g = (lu / ((NCH / BM) * 4)) * 8 + (bid & 7); r = lu % ((NCH / BM) * 4); }
                const int ct = r >> 2, nt = r & 3;
                AS5 af{Ub, CAR, g};
                f32x4 acc[MT][4]; zero_acc<4>(acc);
                gemm_main<4, true>(acc, af, ct * BM, MTC + (size_t)g * 512 * 768, 768, nt * 128, 768, smem);
#pragma unroll
                for (int m = 0; m < MT; ++m) { const int chunk = ct * BM + wr * WM + m * 16 + lr;
#pragma unroll
                    for (int n = 0; n < 4; ++n) { const int ii = nt * 8 + wc * 4 + n; const size_t tok = (size_t)chunk * 32 + ii;
                        st4bf(Zb + tok * DM + g * 16 + 4 * lg, gelu_tanh(acc[m][n][0]), gelu_tanh(acc[m][n][1]), gelu_tanh(acc[m][n][2]), gelu_tanh(acc[m][n][3])); } }
            }
        }
        if (PM & 2) for (int it = bid; it < n_mem; it += nb) {
            PHASE_IDS
            {
                const int i2 = it, tq = i2 >> 2, head = i2 & 3;
                const int t0 = tq * (MEM_MQ * 64); int s0, L; seq_info(t0, s0, L);
                const int b = t0 < TP ? t0 / 2048 : 16 + (t0 - TP) / 4096;
                float bnd;
                { float gg = 0.f;
#pragma unroll
                  for (int e = 0; e < 4; ++e) gg = fmaxf(gg, fabsf(p.mem_q_g[lane * 4 + e] * p.mem_k_g[lane * 4 + e]));
#pragma unroll
                  for (int o = 32; o > 0; o >>= 1) gg = fmaxf(gg, __shfl_xor(gg, o));
                  bnd = fminf(256.f * gg * (0.0625f * 1.4426950408889634f), 60.f); }
                bf16x8 Qf[MEM_MQ][8];
#pragma unroll
                for (int mq = 0; mq < MEM_MQ; ++mq) {
                    const int qrow = t0 + w * (MEM_MQ * 16) + mq * 16 + lr;
                    uint4 raw[8]; float ss = 0.f;
#pragma unroll
                    for (int kk = 0; kk < 8; ++kk) { raw[kk] = *(const uint4*)(QM + (size_t)qrow * DM + head * 256 + kk * 32 + lg * 8);
                        const unsigned ww[4] = {raw[kk].x, raw[kk].y, raw[kk].z, raw[kk].w};
#pragma unroll
                        for (int e = 0; e < 4; ++e) { const float a = bflo(ww[e]), c = bfhi(ww[e]); ss += a * a + c * c; } }
                    ss += __shfl_xor(ss, 16); ss += __shfl_xor(ss, 32);
                    const float sc = rsqrtf(ss * (1.f / 256.f) + EPS) * (0.0625f * 1.4426950408889634f);
#pragma unroll
                    for (int kk = 0; kk < 8; ++kk) { const int d0 = kk * 32 + lg * 8;
                        const unsigned ww[4] = {raw[kk].x, raw[kk].y, raw[kk].z, raw[kk].w}; unsigned oo[4];
#pragma unroll
                        for (int e = 0; e < 4; ++e) { const int d = d0 + 2 * e;
                            oo[e] = pk2(bflo(ww[e]) * sc * p.mem_q_g[d] * p.mem_k_g[d], bfhi(ww[e]) * sc * p.mem_q_g[d + 1] * p.mem_k_g[d + 1]); }
                        uint4 pw; pw.x = oo[0]; pw.y = oo[1]; pw.z = oo[2]; pw.w = oo[3]; Qf[mq][kk] = *(bf16x8*)&pw; }
                }
                f32x4 O[MEM_MQ][16];
                attn_pass<256, 256, MEM_MQ, true, false>(O, Qf, MEMK + (size_t)(b * 256) * DM + head * 256, DM, MEMVT + ((size_t)b * 1024 + head * 256) * 256, 256, 256,
                                                    SSQK + head * 4 * 8192 + b * 256, bnd, smem);
#pragma unroll
                for (int mq = 0; mq < MEM_MQ; ++mq) {
                    bf16_t* dst = QM + (size_t)(t0 + w * (MEM_MQ * 16) + mq * 16 + lr) * DM + head * 256 + 4 * lg;
#pragma unroll
                    for (int n = 0; n < 16; ++n) st4bf(dst + n * 16, O[mq][n][0], O[mq][n][1], O[mq][n][2], O[mq][n][3]);
                }
            }
        }
    }
    GRID_SYNC();

    {
        const int n_glu = (TT / BM) * 8;
        for (int it = bid; it < n_glu + TT / 4; it += nb) {
            PHASE_IDS
            if (it < n_glu) {
                const int mt = (it >> 6) * 8 + (it & 7), nt = (it >> 3) & 7, row0 = mt * BM, n0 = nt * 128;
                APlain af{Zb, DM};
                f32x4 acc[MT][4]; zero_acc<4>(acc);
                gemm_main<4, true>(acc, af, row0, WT_GLU, DM, n0, DM, smem);
#pragma unroll
                for (int m = 0; m < MT; ++m) { const int row = row0 + wr * WM + m * 16 + lr;
#pragma unroll
                    for (int n = 0; n < 4; ++n) { const size_t o = (size_t)row * DM + n0 + wc * 64 + n * 16 + 4 * lg; const uint2 zz = *(const uint2*)(Zb + o);
                        st4bf(S5O + o, bflo(zz.x) * sigmoidf_(acc[m][n][0]), bfhi(zz.x) * sigmoidf_(acc[m][n][1]), bflo(zz.y) * sigmoidf_(acc[m][n][2]), bfhi(zz.y) * sigmoidf_(acc[m][n][3])); } }
            } else {
                const int t = (it - n_glu) * 4 + w; const float* src = t < TP ? p.x_p + (size_t)t * DM : p.x_s + (size_t)(t - TP) * DM; rms_row(src, p.norm_mix_g, HR + (size_t)t * DM, lane);
            }
        }
    }
    GRID_SYNC();

    if (PM & 8) for (int it = bid; it < (TT / BM) * 8; it += nb) {
        PHASE_IDS
        const int mt = (it >> 6) * 8 + (it & 7), nt = (it >> 3) & 7, row0 = mt * BM, n0 = nt * 128;
#pragma unroll 1
        for (int n3 = 0; n3 < 3; ++n3) {
            unsigned gpk[MT][4][2];
            {
                f32x4 ga[MT][4]; zero_acc<4>(ga);
                APlain af{HR, DM}; gemm_main_pf<4, true, 2>(ga, af, row0, WT_IN + (size_t)(5120 + n3 * 1024) * DM, DM, n0, DM, smem);
#pragma unroll
                for (int n = 0; n < 4; ++n) { const f32x4 bg = *(const f32x4*)(p.b_gate + n3 * 1024 + n0 + wc * 64 + n * 16 + 4 * lg);
#pragma unroll
                    for (int m = 0; m < MT; ++m) { gpk[m][n][0] = pk2(sigmoidf_(ga[m][n][0] + bg[0]), sigmoidf_(ga[m][n][1] + bg[1]));
                                                   gpk[m][n][1] = pk2(sigmoidf_(ga[m][n][2] + bg[2]), sigmoidf_(ga[m][n][3] + bg[3])); } }
            }
            f32x4 ba[MT][4]; zero_acc<4>(ba);
            { APlain af{n3 == 0 ? S5O : (n3 == 1 ? Qb : QM), DM}; gemm_main_pf<4, true, 2>(ba, af, row0, WT_BR + (size_t)n3 * 1024 * 1024, DM, n0, DM, smem); }
#pragma unroll
            for (int m = 0; m < MT; ++m) { const int row = row0 + wr * WM + m * 16 + lr;
#pragma unroll
                for (int n = 0; n < 4; ++n) {
                    unsigned long long* dst = (unsigned long long*)(MRG + (size_t)row * DM + n0 + wc * 64 + n * 16 + 4 * lg);
                    unsigned lo = 0u, hi = 0u;
                    if (n3 > 0) { const unsigned long long old = __hip_atomic_load(dst, __ATOMIC_RELAXED, __HIP_MEMORY_SCOPE_AGENT); lo = (unsigned)old; hi = (unsigned)(old >> 32); }
                    lo = pk2(fmaf(bflo(gpk[m][n][0]), ba[m][n][0], bflo(lo)), fmaf(bfhi(gpk[m][n][0]), ba[m][n][1], bfhi(lo)));
                    hi = pk2(fmaf(bflo(gpk[m][n][1]), ba[m][n][2], bflo(hi)), fmaf(bfhi(gpk[m][n][1]), ba[m][n][3], bfhi(hi)));
                    *dst = ((unsigned long long)hi << 32) | lo; } }
        }
    }
    GRID_SYNC();

    for (int it = bid; it < (TT / BM) * 8; it += nb) {
        PHASE_IDS
        const int mt = (it >> 6) * 8 + (it & 7), nt = (it >> 3) & 7, row0 = mt * BM, n0 = nt * 128;
        APlain af{MRG, DM};
        f32x4 acc[MT][4]; zero_acc<4>(acc);
        gemm_main<4, true>(acc, af, row0, WT_OUT, DM, n0, DM, smem);
#pragma unroll
        for (int m = 0; m < MT; ++m) { const int row = row0 + wr * WM + m * 16 + lr;
            const float* xr = row < TP ? p.x_p + (size_t)row * DM : p.x_s + (size_t)(row - TP) * DM;
#pragma unroll
            for (int n = 0; n < 4; ++n) { const int col = n0 + wc * 64 + n * 16 + 4 * lg; const f32x4 xv = *(const f32x4*)(xr + col);
                *(f32x4*)(p.out + (size_t)row * DM + col) = xv + acc[m][n]; } }
    }
    GRID_SYNC();

    for (int it = bid; it < TT / 4; it += nb) { PHASE_IDS const int t = it * 4 + w; rms_row(p.out + (size_t)t * DM, p.ffn_norm_g, H2 + (size_t)t * DM, lane); }
    GRID_SYNC();

#ifdef REP9
    for (int rep = 0; rep < REP9; ++rep)
#endif
    for (int it = bid; it < (TT / BM) * 44; it += nb) {
        PHASE_IDS
        const int mt = it / 44, jt = it % 44, row0 = mt * BM, n0 = jt * 128;
        APlain af{H2, DM};
        f32x4 acc[MT][4]; zero_acc<4>(acc);
        gemm_main<4, true>(acc, af, row0, WT_GU, DM, n0, DM, smem);
#pragma unroll
        for (int m = 0; m < MT; ++m) { const int row = row0 + wr * WM + m * 16 + lr;
#pragma unroll
            for (int pi = 0; pi < 2; ++pi) { const f32x4 gg = acc[m][2 * pi], uu = acc[m][2 * pi + 1];
                st4bf(ACT + (size_t)row * DFF + jt * 64 + wc * 32 + pi * 16 + 4 * lg, gg[0] * sigmoidf_(gg[0]) * uu[0], gg[1] * sigmoidf_(gg[1]) * uu[1], gg[2] * sigmoidf_(gg[2]) * uu[2], gg[3] * sigmoidf_(gg[3]) * uu[3]); } }
    }
    GRID_SYNC();

    for (int it = bid; it < (TT / BM) * 8; it += nb) {
        PHASE_IDS
        const int mt = (it >> 6) * 8 + (it & 7), nt = (it >> 3) & 7, row0 = mt * BM, n0 = nt * 128;
        APlain af{ACT, DFF};
        f32x4 acc[MT][4]; zero_acc<4>(acc);
        gemm_main_pf<4, true, 2>(acc, af, row0, WT_DN, DFF, n0, DFF, smem);
#pragma unroll
        for (int m = 0; m < MT; ++m) { const int row = row0 + wr * WM + m * 16 + lr;
#pragma unroll
            for (int n = 0; n < 4; ++n) { float* o = p.out + (size_t)row * DM + n0 + wc * 64 + n * 16 + 4 * lg; const f32x4 xv = *(const f32x4*)o; *(f32x4*)o = xv + acc[m][n]; } }
    }
}

extern "C" void kernel_launch(void* const* d_in, const int* in_sizes, int n_in, void* d_out, int out_size, void* d_ws, size_t ws_size, hipStream_t stream) {
    static int grid_blocks = 0;
    if (!grid_blocks) {
        int dev = 0, cus = 0, per_cu = 0;
        hipGetDevice(&dev);
        hipDeviceGetAttribute(&cus, hipDeviceAttributeMultiprocessorCount, dev);
        hipFuncSetAttribute((const void*)fwd_megakernel, hipFuncAttributeMaxDynamicSharedMemorySize, LDS_BYTES);
        hipOccupancyMaxActiveBlocksPerMultiprocessor(&per_cu, fwd_megakernel, 256, LDS_BYTES);
        if (per_cu > 2) per_cu = 2;
        if (per_cu < 1) per_cu = 1;
        grid_blocks = cus * per_cu;
    }
    if (ws_size < OFF_END) { fprintf(stderr, "workspace too small: %zu\n", ws_size); return; }
    Params p{};
    const float* const* in = (const float* const*)d_in;
    p.x_p = in[0]; p.x_s = in[1]; p.mem_p = in[2]; p.mem_s = in[3]; p.norm_mix_g = in[4]; p.w_in = in[5]; p.b_gate = in[6];
    p.lam_re = in[7]; p.lam_im = in[8]; p.log_dt = in[9]; p.b_re = in[10]; p.b_im = in[11]; p.c_re = in[12]; p.c_im = in[13];
    p.s5_d = in[14]; p.w_glu = in[15]; p.q_g = in[16]; p.k_g = in[17]; p.lq1 = in[18]; p.lk1 = in[19]; p.lq2 = in[20]; p.lk2 = in[21]; p.sub_g = in[22];
    p.mem_norm_g = in[23]; p.w_mkv = in[24]; p.mem_q_g = in[25]; p.mem_k_g = in[26]; p.w_branch = in[27]; p.w_out = in[28]; p.ffn_norm_g = in[29];
    p.w_gu = in[30]; p.w_dn = in[31];
    p.out = (float*)d_out; p.ws = (char*)d_ws;
    void* args[] = {&p};
    hipError_t e = hipLaunchCooperativeKernel((void*)fwd_megakernel, dim3(grid_blocks), dim3(256), args, LDS_BYTES, stream);
    if (e != hipSuccess) fprintf(stderr, "cooperative launch failed: %s (grid %d)\n", hipGetErrorString(e), grid_blocks);
}
```

```cpp
#include <hip/hip_runtime.h>
#include <hip/hip_cooperative_groups.h>
#include <cstdio>
#include <cstdint>
namespace cg = cooperative_groups;
#ifndef ATT_PIPE
#define ATT_PIPE 2
#endif
#ifndef GEMM_PF
#define GEMM_PF 3
#endif

typedef unsigned short bf16_t;
typedef short bf16x8 __attribute__((ext_vector_type(8)));
typedef float f32x4 __attribute__((ext_vector_type(4)));
typedef unsigned u32x4 __attribute__((ext_vector_type(4)));

constexpr int DM = 1024;
constexpr int TP = 16 * 2048, TS = 16 * 4096, TT = TP + TS;
constexpr int NCH = TT / 32;
constexpr int DFF = 2816;
constexpr float EPS = 1e-6f;
constexpr size_t MiB = 1024ull * 1024ull;
constexpr int MT = 4, BM = 32 * MT, WM = 16 * MT;
constexpr int LDS_BYTES = 81920;

constexpr size_t OFF_WT_IN = 0, OFF_WT_GLU = 16 * MiB, OFF_WT_MKV = 18 * MiB, OFF_WT_BR = 22 * MiB, OFF_WT_OUT = 28 * MiB,
                 OFF_WT_GU = 30 * MiB, OFF_WT_DN = 41 * MiB, OFF_ROPE = 46 * MiB + 512 * 1024, OFF_SSQK = 47 * MiB + 512 * 1024,
                 OFF_MEMN = 48 * MiB, OFF_MEMK = 64 * MiB, OFF_MEMVT = 80 * MiB, OFF_H = 96 * MiB, OFF_U = 288 * MiB, OFF_Q = 480 * MiB,
                 OFF_K = 672 * MiB, OFF_MA = 864 * MiB, OFF_MTC = 880 * MiB, OFF_CAR = 928 * MiB, OFF_END = 1024 * MiB;
constexpr size_t OFF_KC = OFF_CAR;
constexpr size_t OFF_Z = OFF_H;
constexpr size_t OFF_S5OUT = OFF_U;
constexpr size_t OFF_MERGED = OFF_K;
constexpr size_t OFF_ACT = OFF_H;
constexpr size_t OFF_H2 = OFF_K;
constexpr size_t DOFF_QM = 0, DOFF_VT = 192 * MiB;

struct Params {
    const float* x_p; const float* x_s; const float* mem_p; const float* mem_s;
    const float* norm_mix_g; const float* w_in; const float* b_gate;
    const float* lam_re; const float* lam_im; const float* log_dt; const float* b_re; const float* b_im; const float* c_re; const float* c_im;
    const float* s5_d; const float* w_glu;
    const float* q_g; const float* k_g; const float* lq1; const float* lk1; const float* lq2; const float* lk2; const float* sub_g;
    const float* mem_norm_g; const float* w_mkv; const float* mem_q_g; const float* mem_k_g;
    const float* w_branch; const float* w_out; const float* ffn_norm_g; const float* w_gu; const float* w_dn;
    float* out; char* ws;
};

typedef __bf16 bf16v2_t __attribute__((ext_vector_type(2)));
typedef float f32v2_t __attribute__((ext_vector_type(2)));
__device__ __forceinline__ unsigned pk2(float lo, float hi) { f32v2_t v = {lo, hi}; bf16v2_t b = __builtin_convertvector(v, bf16v2_t); return __builtin_bit_cast(unsigned, b); }
__device__ __forceinline__ float bf2f(unsigned short v) { return __uint_as_float(((unsigned)v) << 16); }
__device__ __forceinline__ float bflo(unsigned v) { return __uint_as_float(v << 16); }
__device__ __forceinline__ float bfhi(unsigned v) { return __uint_as_float(v & 0xffff0000u); }
__device__ __forceinline__ void st4bf(bf16_t* p, float a, float b, float c, float d) { uint2 v; v.x = pk2(a, b); v.y = pk2(c, d); *(uint2*)p = v; }
__device__ __forceinline__ float sigmoidf_(float x) { return 1.f / (1.f + __expf(-x)); }
__device__ __forceinline__ float gelu_tanh(float y) { float a = 0.7978845608028654f * (y + 0.044715f * y * y * y); float e = __expf(2.f * a); float t = 1.f - 2.f / (e + 1.f); return 0.5f * y * (1.f + t); }
__device__ __forceinline__ void seq_info(int t, int& s0, int& L) { if (t < TP) { L = 2048; s0 = t & ~2047; } else { L = 4096; s0 = TP + ((t - TP) & ~4095); } }
__device__ __forceinline__ int opaque_tid() { int t = threadIdx.x; asm volatile("" : "+v"(t)); return t; }
#define PHASE_IDS const int tid = opaque_tid(), lane = tid & 63, w = tid >> 6, wr = w >> 1, wc = w & 1, lr = lane & 15, lg = lane >> 4; (void)wr; (void)wc; (void)lr; (void)lg; (void)w; (void)lane;
#define MFMA16(a, b, c) __builtin_amdgcn_mfma_f32_16x16x32_bf16((a), (b), (c), 0, 0, 0)

struct APlain { const bf16_t* A; int lda; __device__ __forceinline__ const bf16_t* operator()(int row, int k) const { return A + (size_t)row * lda + k; } };
struct AS5 { const bf16_t* U; const bf16_t* CAR; int g;
    __device__ __forceinline__ const bf16_t* operator()(int chunk, int k) const {
        return k < 512 ? U + ((size_t)g * NCH + chunk) * 512 + k : CAR + ((size_t)g * NCH + chunk) * 256 + (k - 512); } };

template <int NT, bool SWAP, int PF, class AF>
__device__ __forceinline__ void gemm_main_pf(f32x4 (&acc)[MT][NT], const AF& af, int row0, const bf16_t* __restrict__ Bt, int ldb, int n0, int K, char* lds) {
    const int tid = opaque_tid(), lane = tid & 63, w = tid >> 6, wr = w >> 1, wc = w & 1, lr = lane & 15, lg = lane >> 4;
    constexpr int NB = NT;
    constexpr int AB = BM * 128, STG = (BM + NT * 32) * 128;
    const int ldr = tid >> 3, ldc = tid & 7;
    const int swz = ((ldc ^ (ldr & 7)) << 4);
    u32x4 ra0[MT], rb0[NB], ra1[MT], rb1[NB];
    const int nk = K >> 6;
#define GM_GLOAD(RA, RB, KT) { const int k_ = (KT) * 64 + ldc * 8; _Pragma("unroll") for (int i = 0; i < MT; ++i) RA[i] = *(const u32x4*)af(row0 + ldr + 32 * i, k_); \
                       _Pragma("unroll") for (int i = 0; i < NB; ++i) RB[i] = *(const u32x4*)(Bt + (size_t)(n0 + ldr + 32 * i) * ldb + k_); }
#define GM_LSTORE(RA, RB, ST_) { char* base_ = lds + (ST_) * STG; _Pragma("unroll") for (int i = 0; i < MT; ++i) *(u32x4*)(base_ + (ldr + 32 * i) * 128 + swz) = RA[i]; \
                       _Pragma("unroll") for (int i = 0; i < NB; ++i) *(u32x4*)(base_ + AB + (ldr + 32 * i) * 128 + swz) = RB[i]; }
#define GM_COMPUTE(ST_) { const char* base = lds + (ST_) * STG; \
        _Pragma("unroll") for (int kk = 0; kk < 2; ++kk) { \
            bf16x8 fa[MT], fb[NT]; \
            const int co = (((kk * 4 + lg) ^ (lr & 7)) << 4); \
            _Pragma("unroll") for (int m = 0; m < MT; ++m) fa[m] = *(const bf16x8*)(base + (wr * WM + m * 16 + lr) * 128 + co); \
            _Pragma("unroll") for (int n = 0; n < NT; ++n) fb[n] = *(const bf16x8*)(base + AB + (wc * (NT * 16) + n * 16 + lr) * 128 + co); \
            _Pragma("unroll") for (int m = 0; m < MT; ++m) _Pragma("unroll") for (int n = 0; n < NT; ++n) acc[m][n] = SWAP ? MFMA16(fb[n], fa[m], acc[m][n]) : MFMA16(fa[m], fb[n], acc[m][n]); } }
    if constexpr (PF == 2) {
    GM_GLOAD(ra0, rb0, 0); GM_LSTORE(ra0, rb0, 0); GM_GLOAD(ra1, rb1, 1); __syncthreads();
    for (int kt = 0; kt < nk; kt += 2) {
        { const int k2 = kt + 2 < nk ? kt + 2 : nk - 1; GM_GLOAD(ra0, rb0, k2); }
        GM_COMPUTE(0);
        GM_LSTORE(ra1, rb1, 1);
        __syncthreads();
        { const int k3 = kt + 3 < nk ? kt + 3 : nk - 1; GM_GLOAD(ra1, rb1, k3); }
        GM_COMPUTE(1);
        if (kt + 2 < nk) GM_LSTORE(ra0, rb0, 0);
        __syncthreads();
    }
    } else if constexpr (PF == 3) {
    u32x4 ra2[MT], rb2[NB];
    GM_GLOAD(ra0, rb0, 0); GM_LSTORE(ra0, rb0, 0); GM_GLOAD(ra1, rb1, 1); { const int k2 = 2 < nk ? 2 : nk - 1; GM_GLOAD(ra2, rb2, k2); } __syncthreads();
#define GM_STEP(KT, RL_A, RL_B, RS_A, RS_B) { const int kt_ = (KT); \
        { const int k3 = kt_ + 3 < nk ? kt_ + 3 : nk - 1; GM_GLOAD(RL_A, RL_B, k3); } \
        GM_COMPUTE(kt_ & 1); \
        if (kt_ + 1 < nk) GM_LSTORE(RS_A, RS_B, (kt_ + 1) & 1); \
        __syncthreads(); }
    for (int kt = 0; kt < nk; kt += 3) {
        GM_STEP(kt, ra0, rb0, ra1, rb1);
        if (kt + 1 >= nk) break;
        GM_STEP(kt + 1, ra1, rb1, ra2, rb2);
        if (kt + 2 >= nk) break;
        GM_STEP(kt + 2, ra2, rb2, ra0, rb0);
    }
    } else {
    GM_GLOAD(ra0, rb0, 0); GM_LSTORE(ra0, rb0, 0); __syncthreads();
    for (int kt = 0; kt < nk; kt += 2) {
        GM_GLOAD(ra0, rb0, kt + 1);
        GM_COMPUTE(0);
        GM_LSTORE(ra0, rb0, 1);
        __syncthreads();
        { const int k2 = kt + 2 < nk ? kt + 2 : nk - 1; GM_GLOAD(ra0, rb0, k2); }
        GM_COMPUTE(1);
        if (kt + 2 < nk) GM_LSTORE(ra0, rb0, 0);
        __syncthreads();
    }
    }
}
template <int NT, bool SWAP, class AF>
__device__ __forceinline__ void gemm_main(f32x4 (&acc)[MT][NT], const AF& af, int row0, const bf16_t* __restrict__ Bt, int ldb, int n0, int K, char* lds) {
    gemm_main_pf<NT, SWAP, (NT == 4 ? GEMM_PF : 2)>(acc, af, row0, Bt, ldb, n0, K, lds);
}
template <int NT> __device__ __forceinline__ void zero_acc(f32x4 (&acc)[MT][NT]) {
#pragma unroll
    for (int m = 0; m < MT; ++m)
#pragma unroll
        for (int n = 0; n < NT; ++n) acc[m][n] = (f32x4){0.f, 0.f, 0.f, 0.f};
}

__device__ __forceinline__ void wait_vm6() { asm volatile("s_waitcnt vmcnt(6)" ::: "memory"); }
__device__ __forceinline__ void wait_vm0() { asm volatile("s_waitcnt vmcnt(0)" ::: "memory"); }
template <int DH> __device__ __forceinline__ int kswz(int row, int c) { return DH == 64 ? row * 128 + ((c ^ (row & 7)) << 4) : row * 512 + ((c ^ (row & 15)) << 4); }
template <int DH, int E, int MQ, bool KSC, bool DB>
__device__ __forceinline__ void attn_pass(f32x4 (&O)[MQ][E / 16], const bf16x8 (&Qf)[MQ][DH / 32], const bf16_t* __restrict__ Kp, int ldk,
                                          const bf16_t* __restrict__ Vt, int ldv, int nkeys, const float* __restrict__ ksq, float bnd, char* lds) {
    constexpr int KB = 64 * DH * 2, VB = E * 128, ST = KB + VB, KC = DH / 8, NKL = 64 * KC / 256, NVL = E * 8 / 256;
    const int tid = opaque_tid(), lane = tid & 63, lr = lane & 15, lg = lane >> 4;
    float lsum[MQ];
#pragma unroll
    for (int q = 0; q < MQ; ++q) { lsum[q] = 0.f;
#pragma unroll
        for (int n = 0; n < E / 16; ++n) O[q][n] = (f32x4){0.f, 0.f, 0.f, 0.f}; }
    u32x4 rk[NKL], rv[NVL];
#define GLOADK(T) { const int key0_ = (T) * 64; _Pragma("unroll") for (int i = 0; i < NKL; ++i) { const int q = tid + 256 * i, r = q / KC, c = q % KC; rk[i] = *(const u32x4*)(Kp + (size_t)(key0_ + r) * ldk + c * 8); } }
#define GLOADV(T) { const int key0_ = (T) * 64; _Pragma("unroll") for (int i = 0; i < NVL; ++i) { const int q = tid + 256 * i, e = q >> 3, c = q & 7; rv[i] = *(const u32x4*)(Vt + (size_t)e * ldv + key0_ + c * 8); } }
#define LSTOREK(STG) { char* base_ = lds + (STG) * ST; _Pragma("unroll") for (int i = 0; i < NKL; ++i) { const int q = tid + 256 * i, r = q / KC, c = q % KC; *(u32x4*)(base_ + kswz<DH>(r, c)) = rk[i]; } }
#define LSTOREV(STG) { char* base_ = lds + (STG) * ST; _Pragma("unroll") for (int i = 0; i < NVL; ++i) { const int q = tid + 256 * i, e = q >> 3, c = q & 7; *(u32x4*)(base_ + KB + e * 128 + ((c ^ ((e >> 1) & 7)) << 4)) = rv[i]; } }
#define ATT_QK(S_, BASE_, SINIT_) { \
        _Pragma("unroll") for (int q = 0; q < MQ; ++q) _Pragma("unroll") for (int k4 = 0; k4 < 4; ++k4) S_[q][k4] = (f32x4){SINIT_, SINIT_, SINIT_, SINIT_}; \
        _Pragma("unroll") for (int k4 = 0; k4 < 4; ++k4) _Pragma("unroll") for (int kk = 0; kk < DH / 32; ++kk) { \
            const bf16x8 kf = *(const bf16x8*)((BASE_) + kswz<DH>(k4 * 16 + lr, kk * 4 + lg)); \
            __builtin_amdgcn_s_setprio(1); _Pragma("unroll") for (int q = 0; q < MQ; ++q) S_[q][k4] = MFMA16(kf, Qf[q][kk], S_[q][k4]); __builtin_amdgcn_s_setprio(0); } }
#define ATT_SOFTMAX(S_) { \
        _Pragma("unroll") for (int q = 0; q < MQ; ++q) { float ps = 0.f; \
            _Pragma("unroll") for (int k4 = 0; k4 < 4; ++k4) _Pragma("unroll") for (int j = 0; j < 4; ++j) { const float pv = __builtin_amdgcn_exp2f(S_[q][k4][j]); S_[q][k4][j] = pv; ps += pv; } \
            lsum[q] += ps; \
            _Pragma("unroll") for (int k2 = 0; k2 < 2; ++k2) { uint4 pw; pw.x = pk2(S_[q][2 * k2][0], S_[q][2 * k2][1]); pw.y = pk2(S_[q][2 * k2][2], S_[q][2 * k2][3]); \
                pw.z = pk2(S_[q][2 * k2 + 1][0], S_[q][2 * k2 + 1][1]); pw.w = pk2(S_[q][2 * k2 + 1][2], S_[q][2 * k2 + 1][3]); Pf[q][k2] = *(bf16x8*)&pw; } } }
#define ATT_PV(BASE_) { \
        _Pragma("unroll") for (int k2 = 0; k2 < 2; ++k2) _Pragma("unroll") for (int n = 0; n < E / 16; ++n) { \
            const char* rowp = (BASE_) + KB + n * 2048; \
            uint4 vw; const uint2 v0 = *(const uint2*)(rowp + (k2 == 0 ? vo00 : vo10)), v1 = *(const uint2*)(rowp + (k2 == 0 ? vo01 : vo11)); \
            vw.x = v0.x; vw.y = v0.y; vw.z = v1.x; vw.w = v1.y; const bf16x8 vf = *(bf16x8*)&vw; \
            __builtin_amdgcn_s_setprio(1); _Pragma("unroll") for (int q = 0; q < MQ; ++q) O[q][n] = MFMA16(vf, Pf[q][k2], O[q][n]); __builtin_amdgcn_s_setprio(0); } }
    const int vsw = (lr >> 1) & 7;
    const int vo00 = lr * 128 + (lg & 1) * 8 + ((((lg >> 1)) ^ vsw) << 4), vo01 = lr * 128 + (lg & 1) * 8 + ((((lg >> 1) + 2) ^ vsw) << 4);
    const int vo10 = lr * 128 + (lg & 1) * 8 + (((4 + (lg >> 1)) ^ vsw) << 4), vo11 = lr * 128 + (lg & 1) * 8 + (((6 + (lg >> 1)) ^ vsw) << 4);
    const int nt = nkeys >> 6;
    bf16x8 Pf[MQ][2];
#if ATT_PIPE == 2
    if (DB) {
        const float sinit = -bnd;
        f32x4 Sc[MQ][4];
#define ATT_ISSUE(T, STG) { const int key0_ = (T) * 64; char* sb_ = lds + (STG) * ST + tid * 16; \
        _Pragma("unroll") for (int i = 0; i < NKL; ++i) { const int L_ = tid + 256 * i, r = L_ / KC, c = (L_ % KC) ^ (r & 7); \
            __builtin_amdgcn_global_load_lds((const unsigned*)(Kp + (size_t)(key0_ + r) * ldk + c * 8), (__attribute__((address_space(3))) unsigned*)(sb_ + i * 4096), 16, 0, 0); } \
        _Pragma("unroll") for (int i = 0; i < NVL; ++i) { const int L_ = tid + 256 * i, e = L_ >> 3, c = (L_ & 7) ^ ((e >> 1) & 7); \
            __builtin_amdgcn_global_load_lds((const unsigned*)(Vt + (size_t)e * ldv + key0_ + c * 8), (__attribute__((address_space(3))) unsigned*)(sb_ + KB + i * 4096), 16, 0, 0); } }
        static_assert(!DB || (DH == 64 && NKL + NVL == 6), "glds attention path is written for DH = 64, E = 128");
        ATT_ISSUE(0, 0); ATT_ISSUE(1, 1);
        wait_vm6(); __builtin_amdgcn_s_barrier(); asm volatile("" ::: "memory");
        int st = 0;
        for (int t = 0; t < nt; ++t) {
            const int st2 = st == 0 ? 2 : st - 1;
            if (t + 2 < nt) ATT_ISSUE(t + 2, st2);
            ATT_QK(Sc, lds + st * ST, sinit);
            ATT_SOFTMAX(Sc);
            ATT_PV(lds + st * ST);
            if (t + 2 < nt) wait_vm6(); else wait_vm0();
            __builtin_amdgcn_s_barrier(); asm volatile("" ::: "memory");
            st = st == 2 ? 0 : st + 1;
        }
    } else
#elif !ATT_PIPE
    if (DB) {
        const float sinit = -bnd;
        f32x4 Sc[MQ][4];
        GLOADK(0); GLOADV(0); LSTOREK(0); LSTOREV(0); __syncthreads();
        for (int t = 0; t < nt; ++t) {
            { const int t1_ = t + 1 < nt ? t + 1 : nt - 1; GLOADK(t1_); GLOADV(t1_); }
            ATT_QK(Sc, lds + (t & 1) * ST, sinit);
            ATT_SOFTMAX(Sc);
            ATT_PV(lds + (t & 1) * ST);
            if (t + 1 < nt) { LSTOREK((t + 1) & 1); LSTOREV((t + 1) & 1); }
            __syncthreads();
        }
    } else
#endif
    if (DB) {
        const float sinit = -bnd;
        f32x4 Sc[MQ][4], Sn[MQ][4];
        GLOADK(0); GLOADV(0); LSTOREK(0); LSTOREV(0); __syncthreads();
        { const int t1_ = nt > 1 ? 1 : 0; GLOADK(t1_); GLOADV(t1_); }
        ATT_QK(Sc, lds, sinit);
        for (int t = 0; t < nt; ++t) {
            __syncthreads();
            if (t + 1 < nt) { LSTOREK((t + 1) & 1); LSTOREV((t + 1) & 1); }
            __syncthreads();
            { const int t2_ = t + 2 < nt ? t + 2 : nt - 1; GLOADK(t2_); GLOADV(t2_); }
            if (t + 1 < nt) ATT_QK(Sn, lds + ((t + 1) & 1) * ST, sinit);
            ATT_SOFTMAX(Sc);
            ATT_PV(lds + (t & 1) * ST);
#pragma unroll
            for (int q = 0; q < MQ; ++q)
#pragma unroll
                for (int k4 = 0; k4 < 4; ++k4) Sc[q][k4] = Sn[q][k4];
        }
        __syncthreads();
    } else {
        GLOADK(0); LSTOREK(0); GLOADV(0); LSTOREV(0); __syncthreads();
        for (int t = 0; t < nt; ++t) {
            f32x4 Sc[MQ][4];
            ATT_QK(Sc, lds, 0.f);
            if (KSC) {
#pragma unroll
                for (int k4 = 0; k4 < 4; ++k4) {
                    float4 sq = *(const float4*)(ksq + t * 64 + k4 * 16 + 4 * lg);
#pragma unroll
                    for (int pt = 1; pt < 4; ++pt) { const float4 s2 = *(const float4*)(ksq + pt * 8192 + t * 64 + k4 * 16 + 4 * lg); sq.x += s2.x; sq.y += s2.y; sq.z += s2.z; sq.w += s2.w; }
                    const float s0 = rsqrtf(sq.x * (1.f / 256.f) + EPS), s1 = rsqrtf(sq.y * (1.f / 256.f) + EPS), s2 = rsqrtf(sq.z * (1.f / 256.f) + EPS), s3 = rsqrtf(sq.w * (1.f / 256.f) + EPS);
#pragma unroll
                    for (int q = 0; q < MQ; ++q) { Sc[q][k4][0] = fmaf(Sc[q][k4][0], s0, -bnd); Sc[q][k4][1] = fmaf(Sc[q][k4][1], s1, -bnd); Sc[q][k4][2] = fmaf(Sc[q][k4][2], s2, -bnd); Sc[q][k4][3] = fmaf(Sc[q][k4][3], s3, -bnd); }
                }
            } else {
#pragma unroll
                for (int q = 0; q < MQ; ++q)
#pragma unroll
                    for (int k4 = 0; k4 < 4; ++k4) Sc[q][k4] -= bnd;
            }
            ATT_SOFTMAX(Sc);
            ATT_PV(lds);
            __syncthreads();
            if (t + 1 < nt) { GLOADK(t + 1); LSTOREK(0); GLOADV(t + 1); LSTOREV(0); __syncthreads(); }
        }
    }
#pragma unroll
    for (int q = 0; q < MQ; ++q) {
        float l = lsum[q]; l += __shfl_xor(l, 16); l += __shfl_xor(l, 32);
        const float inv = 1.f / l;
#pragma unroll
        for (int n = 0; n < E / 16; ++n) O[q][n] *= inv;
    }
}

__device__ __forceinline__ void rms_row(const float* __restrict__ src, const float* __restrict__ g, bf16_t* __restrict__ dst, int lane) {
    float4 v[4]; float ss = 0.f;
#pragma unroll
    for (int i = 0; i < 4; ++i) { v[i] = *(const float4*)(src + (i * 64 + lane) * 4); ss += v[i].x * v[i].x + v[i].y * v[i].y + v[i].z * v[i].z + v[i].w * v[i].w; }
#pragma unroll
    for (int o = 32; o > 0; o >>= 1) ss += __shfl_xor(ss, o);
    const float rstd = rsqrtf(ss * (1.f / 1024.f) + EPS);
#pragma unroll
    for (int i = 0; i < 4; ++i) { const float4 gg = *(const float4*)(g + (i * 64 + lane) * 4);
        st4bf(dst + (i * 64 + lane) * 4, v[i].x * rstd * gg.x, v[i].y * rstd * gg.y, v[i].z * rstd * gg.z, v[i].w * rstd * gg.w); }
}

template <bool PERM_GU>
__device__ __forceinline__ void transpose_w(const float* __restrict__ src, int K, int N, bf16_t* __restrict__ dst, char* lds) {
    float* T = (float*)lds;
    const int tid = opaque_tid(), tk = K / 64, tn = N / 64;
    for (int t = blockIdx.x; t < tk * tn; t += gridDim.x) {
        const int k0 = (t / tn) * 64, n0 = (t % tn) * 64;
#pragma unroll
        for (int i = 0; i < 16; ++i) { const int kr = (tid >> 6) + 4 * i, nc = tid & 63; T[kr * 65 + nc] = src[(size_t)(k0 + kr) * N + n0 + nc]; }
        __syncthreads();
        const int nl = tid >> 2, ks = (tid & 3) * 16;
        int n = n0 + nl;
        if (PERM_GU) { const int isup = n >= DFF ? 1 : 0; const int c = n - isup * DFF; n = (c >> 6) * 128 + ((c >> 5) & 1) * 64 + (((c >> 4) & 1) * 2 + isup) * 16 + (c & 15); }
        uint4 o0, o1;
        o0.x = pk2(T[(ks + 0) * 65 + nl], T[(ks + 1) * 65 + nl]); o0.y = pk2(T[(ks + 2) * 65 + nl], T[(ks + 3) * 65 + nl]);
        o0.z = pk2(T[(ks + 4) * 65 + nl], T[(ks + 5) * 65 + nl]); o0.w = pk2(T[(ks + 6) * 65 + nl], T[(ks + 7) * 65 + nl]);
        o1.x = pk2(T[(ks + 8) * 65 + nl], T[(ks + 9) * 65 + nl]); o1.y = pk2(T[(ks + 10) * 65 + nl], T[(ks + 11) * 65 + nl]);
        o1.z = pk2(T[(ks + 12) * 65 + nl], T[(ks + 13) * 65 + nl]); o1.w = pk2(T[(ks + 14) * 65 + nl], T[(ks + 15) * 65 + nl]);
        bf16_t* d = dst + (size_t)n * K + k0 + ks;
        *(uint4*)d = o0; *(uint4*)(d + 8) = o1;
        __syncthreads();
    }
}

__device__ __forceinline__ float2 cmul(float2 a, float2 b) { return make_float2(a.x * b.x - a.y * b.y, a.x * b.y + a.y * b.x); }
__device__ __forceinline__ void s5_prep(const Params& p, int g, int dir, char* lds) {
    float2* POW = (float2*)lds;
    float2* BB = POW + 33 * 64;
    float2* CC = BB + 64 * 16;
    float2* COEF = CC + 16 * 64;
    const int tid = opaque_tid();
    const int gd = dir * 64 + g;
    if (tid < 64) {
        const int pp = tid;
        const float lre = p.lam_re[gd * 64 + pp], lim = p.lam_im[gd * 64 + pp];
        const float dt = expf(p.log_dt[gd]);
        for (int d = 0; d <= 32; ++d) { const float mag = expf((float)d * lre * dt); float sn, cs; sincosf((float)d * lim * dt, &sn, &cs); POW[d * 64 + pp] = make_float2(mag * cs, mag * sn); }
        const float a = lre * dt, b = lim * dt; float sn, cs, sh, ch; sincosf(b, &sn, &cs); sincosf(0.5f * b, &sh, &ch);
        const float nr = expm1f(a) * cs - 2.f * sh * sh, ni = expf(a) * sn;
        const float den = 1.f / (lre * lre + lim * lim);
        COEF[pp] = make_float2((nr * lre + ni * lim) * den, (ni * lre - nr * lim) * den);
    }
    __syncthreads();
    for (int i = tid; i < 1024; i += 256) {
        const int pp = i >> 4, h = i & 15;
        BB[i] = cmul(COEF[pp], make_float2(p.b_re[(gd * 64 + pp) * 16 + h], p.b_im[(gd * 64 + pp) * 16 + h]));
        const int hh = i >> 6, p2 = i & 63;
        CC[i] = make_float2(p.c_re[(gd * 16 + hh) * 64 + p2], p.c_im[(gd * 16 + hh) * 64 + p2]);
    }
    __syncthreads();
    float* Kc = (float*)(p.ws + OFF_KC) + (size_t)(g * 2 + dir) * 32 * 256;
    { const int hp = tid >> 4, h = tid & 15;
      float sacc[32];
#pragma unroll
      for (int d = 0; d < 32; ++d) sacc[d] = 0.f;
#pragma unroll 1
      for (int pp = 0; pp < 64; ++pp) { const float2 wcb = cmul(CC[hp * 64 + pp], BB[pp * 16 + h]);
#pragma unroll
          for (int d = 0; d < 32; ++d) { const float2 pw = POW[d * 64 + pp]; sacc[d] += wcb.x * pw.x - wcb.y * pw.y; } }
#pragma unroll
      for (int d = 0; d < 32; ++d) Kc[d * 256 + tid] = sacc[d]; }
    bf16_t* MA = (bf16_t*)(p.ws + OFF_MA) + ((size_t)g * 256 + dir * 128) * 512;
    for (int i = tid; i < 128 * 512; i += 256) {
        const int k = i & 511, nl = i >> 9, pp = nl >> 1, c = nl & 1, j = k >> 4, h = k & 15;
        const float2 w = cmul(POW[(dir == 0 ? 31 - j : j) * 64 + pp], BB[pp * 16 + h]);
        const float v = c == 0 ? w.x : w.y;
        MA[(size_t)nl * 512 + k] = (bf16_t)(pk2(v, 0.f) & 0xffff);
    }
    bf16_t* MTC = (bf16_t*)(p.ws + OFF_MTC) + (size_t)g * 512 * 768 + 512 + dir * 128;
    for (int i = tid; i < 512 * 128; i += 256) {
        const int cl = i & 127, row = i >> 7, pp = cl >> 1, c = cl & 1, ii = row >> 4, hp = row & 15;
        const float2 w = cmul(CC[hp * 64 + pp], POW[(dir == 0 ? ii + 1 : 32 - ii) * 64 + pp]);
        const float v = c == 0 ? w.x : -w.y;
        MTC[(size_t)row * 768 + cl] = (bf16_t)(pk2(v, 0.f) & 0xffff);
    }
    __syncthreads();
}

#ifndef DIFF_MQ
#define DIFF_MQ 2
#endif
#ifndef MEM_MQ
#define MEM_MQ 1
#endif
#ifndef PM
#define PM 0xffff
#endif
#define GRID_SYNC() do { asm volatile("s_waitcnt vmcnt(0)" ::: "memory"); grid.sync(); } while (0)
__global__ void __launch_bounds__(256, 2) fwd_megakernel(Params p) {
    cg::grid_group grid = cg::this_grid();
    extern __shared__ __attribute__((aligned(16))) char smem[];
    const int nb = gridDim.x, bid = blockIdx.x;
    char* ws = p.ws;
    bf16_t* WT_IN = (bf16_t*)(ws + OFF_WT_IN); bf16_t* WT_GLU = (bf16_t*)(ws + OFF_WT_GLU); bf16_t* WT_MKV = (bf16_t*)(ws + OFF_WT_MKV);
    bf16_t* WT_BR = (bf16_t*)(ws + OFF_WT_BR); bf16_t* WT_OUT = (bf16_t*)(ws + OFF_WT_OUT); bf16_t* WT_GU = (bf16_t*)(ws + OFF_WT_GU); bf16_t* WT_DN = (bf16_t*)(ws + OFF_WT_DN);
    float* ROPE = (float*)(ws + OFF_ROPE); float* SSQK = (float*)(ws + OFF_SSQK);
    bf16_t* MEMN = (bf16_t*)(ws + OFF_MEMN); bf16_t* MEMK = (bf16_t*)(ws + OFF_MEMK); bf16_t* MEMVT = (bf16_t*)(ws + OFF_MEMVT);
    bf16_t* Hh = (bf16_t*)(ws + OFF_H); bf16_t* Ub = (bf16_t*)(ws + OFF_U); bf16_t* Qb = (bf16_t*)(ws + OFF_Q); bf16_t* Kb = (bf16_t*)(ws + OFF_K);
    bf16_t* MA = (bf16_t*)(ws + OFF_MA); bf16_t* MTC = (bf16_t*)(ws + OFF_MTC); bf16_t* CAR = (bf16_t*)(ws + OFF_CAR);
    bf16_t* Zb = (bf16_t*)(ws + OFF_Z); bf16_t* S5O = (bf16_t*)(ws + OFF_S5OUT); bf16_t* MRG = (bf16_t*)(ws + OFF_MERGED); bf16_t* ACT = (bf16_t*)(ws + OFF_ACT); bf16_t* H2 = (bf16_t*)(ws + OFF_H2);
    bf16_t* QM = (bf16_t*)((char*)p.out + DOFF_QM); bf16_t* VT = (bf16_t*)((char*)p.out + DOFF_VT); bf16_t* HR = VT;

    transpose_w<false>(p.w_in, 1024, 8192, WT_IN, smem);
    transpose_w<false>(p.w_glu, 1024, 1024, WT_GLU, smem);
    transpose_w<false>(p.w_mkv, 1024, 2048, WT_MKV, smem);
    for (int n3 = 0; n3 < 3; ++n3) transpose_w<false>(p.w_branch + (size_t)n3 * 1024 * 1024, 1024, 1024, WT_BR + (size_t)n3 * 1024 * 1024, smem);
    transpose_w<false>(p.w_out, 1024, 1024, WT_OUT, smem);
    transpose_w<true>(p.w_gu, 1024, 2 * DFF, WT_GU, smem);
    transpose_w<false>(p.w_dn, DFF, 1024, WT_DN, smem);
    for (int it = bid; it < TT / 4; it += nb) { PHASE_IDS const int t = it * 4 + w; const float* src = t < TP ? p.x_p + (size_t)t * DM : p.x_s + (size_t)(t - TP) * DM; rms_row(src, p.norm_mix_g, Hh + (size_t)t * DM, lane); }
    for (int it = bid; it < 8192 / 4; it += nb) { PHASE_IDS const int r = it * 4 + w; const float* src = r < 4096 ? p.mem_p + (size_t)r * DM : p.mem_s + (size_t)(r - 4096) * DM; rms_row(src, p.mem_norm_g, MEMN + (size_t)r * DM, lane); }
    for (int it = bid; it < 4096 * 32 / 256; it += nb) { PHASE_IDS const int i = it * 256 + tid, pos = i >> 5, d = i & 31;
        const float inv = powf(10000.f, -(float)d / 32.f); float sn, cs; sincosf((float)pos * inv, &sn, &cs); ROPE[pos * 64 + d] = cs; ROPE[pos * 64 + 32 + d] = sn; }
    if (PM & 4) for (int it = bid; it < 128; it += nb) s5_prep(p, it >> 1, it & 1, smem);
    GRID_SYNC();

    {
        const int n_in = (TT / BM) * 40, n_mkv = (8192 / BM) * 16, n_exp = 64 * 512 * 64 / 256;
        for (int it = bid; it < n_in + n_mkv + n_exp; it += nb) {
            PHASE_IDS
            if (it < n_in) {
                const int mt = it / 40, nt = it % 40, seg = nt >> 3, row0 = mt * BM, n0 = nt * 128;
                APlain af{Hh, DM};
                int s0, L; seq_info(row0, s0, L);
                if (seg == 3) {
                    f32x4 acc[MT][4]; zero_acc<4>(acc);
                    gemm_main<4, false>(acc, af, row0, WT_IN, DM, n0, DM, smem);
#pragma unroll
                    for (int m = 0; m < MT; ++m)
#pragma unroll
                        for (int n = 0; n < 4; ++n) { const int pos = row0 - s0 + wr * WM + m * 16 + 4 * lg, col = (nt & 7) * 128 + wc * 64 + n * 16 + lr;
                            st4bf(VT + (size_t)s0 * DM + (size_t)col * L + pos, acc[m][n][0], acc[m][n][1], acc[m][n][2], acc[m][n][3]); }
                } else {
                    f32x4 acc[MT][4]; zero_acc<4>(acc);
                    gemm_main<4, true>(acc, af, row0, WT_IN, DM, n0, DM, smem);
                    const int cb = (nt & 7) * 128 + wc * 64 + 4 * lg;
                    if (seg == 0) {
#pragma unroll
                        for (int m = 0; m < MT; ++m) { const int row = row0 + wr * WM + m * 16 + lr;
#pragma unroll
                            for (int n = 0; n < 4; ++n) { const int g = (nt & 7) * 8 + wc * 4 + n;
                                st4bf(Ub + ((size_t)g * NCH + (row >> 5)) * 512 + (row & 31) * 16 + 4 * lg, acc[m][n][0], acc[m][n][1], acc[m][n][2], acc[m][n][3]); } }
                    } else if (seg == 4) {
#pragma unroll
                        for (int m = 0; m < MT; ++m) { const int row = row0 + wr * WM + m * 16 + lr;
#pragma unroll
                            for (int n = 0; n < 4; ++n) st4bf(QM + (size_t)row * DM + cb + n * 16, acc[m][n][0], acc[m][n][1], acc[m][n][2], acc[m][n][3]); }
                    } else {
                        const float* gain = seg == 1 ? p.q_g : p.k_g; bf16_t* dst = seg == 1 ? Qb : Kb;
                        const float osc = seg == 1 ? 0.125f * 1.4426950408889634f : 1.f;
                        f32x4 gn[4];
#pragma unroll
                        for (int n = 0; n < 4; ++n) gn[n] = *(const f32x4*)(gain + n * 16 + 4 * lg);
#pragma unroll
                        for (int m = 0; m < MT; ++m) { const int row = row0 + wr * WM + m * 16 + lr, pos = row - s0;
                            float ss = 0.f;
#pragma unroll
                            for (int n = 0; n < 4; ++n)
#pragma unroll
                                for (int j = 0; j < 4; ++j) ss += acc[m][n][j] * acc[m][n][j];
                            ss += __shfl_xor(ss, 16); ss += __shfl_xor(ss, 32);
                            const float rstd = rsqrtf(ss * (1.f / 64.f) + EPS);
                            f32x4 o[4];
#pragma unroll
                            for (int n = 0; n < 2; ++n) { const f32x4 cs = *(const f32x4*)(ROPE + pos * 64 + n * 16 + 4 * lg), sn = *(const f32x4*)(ROPE + pos * 64 + 32 + n * 16 + 4 * lg);
#pragma unroll
                                for (int j = 0; j < 4; ++j) { const float x1 = acc[m][n][j] * rstd * gn[n][j], x2 = acc[m][n + 2][j] * rstd * gn[n + 2][j];
                                    o[n][j] = (x1 * cs[j] - x2 * sn[j]) * osc; o[n + 2][j] = (x1 * sn[j] + x2 * cs[j]) * osc; } }
#pragma unroll
                            for (int n = 0; n < 4; ++n) st4bf(dst + (size_t)row * DM + cb + n * 16, o[n][0], o[n][1], o[n][2], o[n][3]); }
                    }
                }
            } else if (it < n_in + n_mkv) {
                const int i2 = it - n_in, mt = i2 / 16, nt = i2 % 16, row0 = mt * BM, n0 = nt * 128;
                APlain af{MEMN, DM};
                if (nt < 8) {
                    f32x4 acc[MT][4]; zero_acc<4>(acc);
                    gemm_main<4, true>(acc, af, row0, WT_MKV, DM, n0, DM, smem);
                    const int cb = nt * 128 + wc * 64 + 4 * lg, head = nt >> 1;
#pragma unroll
                    for (int m = 0; m < MT; ++m) { const int row = row0 + wr * WM + m * 16 + lr; float ss = 0.f;
#pragma unroll
                        for (int n = 0; n < 4; ++n) { st4bf(MEMK + (size_t)row * DM + cb + n * 16, acc[m][n][0], acc[m][n][1], acc[m][n][2], acc[m][n][3]);
#pragma unroll
                            for (int j = 0; j < 4; ++j) ss += acc[m][n][j] * acc[m][n][j]; }
                        ss += __shfl_xor(ss, 16); ss += __shfl_xor(ss, 32);
                        if (lg == 0) SSQK[(head * 4 + (nt & 1) * 2 + wc) * 8192 + row] = ss; }
                } else {
                    f32x4 acc[MT][4]; zero_acc<4>(acc);
                    gemm_main<4, false>(acc, af, row0, WT_MKV, DM, n0, DM, smem);
#pragma unroll
                    for (int m = 0; m < MT; ++m)
#pragma unroll
                        for (int n = 0; n < 4; ++n) { const int row = row0 + wr * WM + m * 16 + 4 * lg, b = row >> 8, key = row & 255, col = (nt - 8) * 128 + wc * 64 + n * 16 + lr;
                            st4bf(MEMVT + ((size_t)b * 1024 + col) * 256 + key, acc[m][n][0], acc[m][n][1], acc[m][n][2], acc[m][n][3]); }
                }
            } else {
                const int i3 = (it - n_in - n_mkv) * 256 + tid;
                const int g = i3 >> 15, row = (i3 >> 6) & 511, kc = i3 & 63, ii = row >> 4, hp = row & 15, j = kc >> 1, h0 = (kc & 1) * 8;
                const float* Kc = (const float*)(ws + OFF_KC) + (size_t)g * 2 * 32 * 256;
                float v[8];
#pragma unroll
                for (int e = 0; e < 8; ++e) v[e] = 0.f;
                if (j <= ii) { const float* s = Kc + (ii - j) * 256 + hp * 16 + h0;
#pragma unroll
                    for (int e = 0; e < 8; ++e) v[e] += s[e]; }
                if (j >= ii) { const float* s = Kc + 32 * 256 + (j - ii) * 256 + hp * 16 + h0;
#pragma unroll
                    for (int e = 0; e < 8; ++e) v[e] += s[e]; }
                if (j == ii) {
#pragma unroll
                    for (int e = 0; e < 8; ++e) if (h0 + e == hp) v[e] += p.s5_d[g * 16 + hp]; }
                uint4 o; o.x = pk2(v[0], v[1]); o.y = pk2(v[2], v[3]); o.z = pk2(v[4], v[5]); o.w = pk2(v[6], v[7]);
                *(uint4*)(MTC + ((size_t)g * 512 + row) * 768 + j * 16 + h0) = o;
            }
        }
    }
    GRID_SYNC();

    for (int it = bid; it < 64 * (NCH / BM) * 2; it += nb) {
        PHASE_IDS
        int g = it / ((NCH / BM) * 2), r = it % ((NCH / BM) * 2);
        if ((nb & 7) == 0 && (64 * (NCH / BM) * 2) % nb == 0) {
            const int lu = (it / nb) * (nb >> 3) + (bid >> 3); g = (lu / ((NCH / BM) * 2)) * 8 + (bid & 7); r = lu % ((NCH / BM) * 2); }
        const int ct = r >> 1, nt = r & 1;
        AS5 af{Ub, CAR, g};
        f32x4 acc[MT][4]; zero_acc<4>(acc);
        gemm_main<4, true>(acc, af, ct * BM, MA + (size_t)g * 256 * 512, 512, nt * 128, 512, smem);
#pragma unroll
        for (int m = 0; m < MT; ++m) { const int chunk = ct * BM + wr * WM + m * 16 + lr;
#pragma unroll
            for (int n = 0; n < 4; ++n) st4bf(CAR + ((size_t)g * NCH + chunk) * 256 + nt * 128 + wc * 64 + n * 16 + 4 * lg, acc[m][n][0], acc[m][n][1], acc[m][n][2], acc[m][n][3]); }
    }
    GRID_SYNC();

    for (int it = bid; it < 32 * 64 * 128 / 256; it += nb) {
        PHASE_IDS
        const int i = it * 256 + tid, pd = i & 127, g = (i >> 7) & 63, b = i >> 13, dir = pd >> 6, pp = pd & 63;
        const int gd = dir * 64 + g;
        const float dt = expf(p.log_dt[gd]);
        const float lre = p.lam_re[gd * 64 + pp], lim = p.lam_im[gd * 64 + pp];
        const float mag = expf(32.f * lre * dt); float sn, cs; sincosf(32.f * lim * dt, &sn, &cs);
        const float ar = mag * cs, ai = mag * sn;
        const int c0 = b < 16 ? b * 64 : 1024 + (b - 16) * 128, nc = b < 16 ? 64 : 128;
        unsigned* base = (unsigned*)(CAR + ((size_t)g * NCH + c0) * 256 + pd * 2);
        float sr = 0.f, si = 0.f;
        for (int c8 = 0; c8 < nc; c8 += 8) {
            unsigned ev[8];
#pragma unroll
            for (int u = 0; u < 8; ++u) { const int cc = dir == 0 ? c8 + u : nc - 1 - (c8 + u); ev[u] = base[(size_t)cc * 128]; }
#pragma unroll
            for (int u = 0; u < 8; ++u) { const int cc = dir == 0 ? c8 + u : nc - 1 - (c8 + u);
                base[(size_t)cc * 128] = pk2(sr, si);
                const float er = bflo(ev[u]), ei = bfhi(ev[u]);
                const float nr = ar * sr - ai * si + er, ni = ar * si + ai * sr + ei;
                sr = nr; si = ni; }
        }
    }
    GRID_SYNC();

    {
        constexpr int DQ = 64 * DIFF_MQ, NQS = 4096 / DQ, NQP = 2048 / DQ;
        const int n_ds = 16 * 8 * NQS, n_dp = 16 * 8 * NQP, n_s5 = 64 * (NCH / BM) * 4, n_mem = (TT / (MEM_MQ * 64)) * 4;
        if (PM & 1) for (int it = bid; it < n_ds + n_dp; it += nb) {
            PHASE_IDS
            {
                int b, h, qt, L, s0;
                if ((nb & 7) == 0 && (n_ds + n_dp) % nb == 0) {
                    const int xcd = bid & 7, slot = bid >> 3, spx = nb >> 3, rnd = it / nb;
                    const int lu = rnd * spx + slot;
                    const int per_s = 16 * NQS;
                    if (lu < per_s) { L = 4096; const int bh = (lu / NQS) * 8 + xcd; qt = lu % NQS; b = bh >> 3; h = bh & 7; s0 = TP + b * 4096; }
                    else { const int l2 = lu - per_s; L = 2048; const int bh = (l2 / NQP) * 8 + xcd; qt = l2 % NQP; b = bh >> 3; h = bh & 7; s0 = b * 2048; }
                } else
                if (it < n_ds) { L = 4096; b = it / (8 * NQS); const int r = it % (8 * NQS); h = r / NQS; qt = r % NQS; s0 = TP + b * 4096; }
                else { const int i2 = it - n_ds; L = 2048; b = i2 / (8 * NQP); const int r = i2 % (8 * NQP); h = r / NQP; qt = r % NQP; s0 = b * 2048; }
                const int q0 = s0 + qt * DQ + w * (16 * DIFF_MQ);
                float bnd;
                { float gq = fabsf(p.q_g[lane]), gk = fabsf(p.k_g[lane]);
#pragma unroll
                  for (int o = 32; o > 0; o >>= 1) { gq = fmaxf(gq, __shfl_xor(gq, o)); gk = fmaxf(gk, __shfl_xor(gk, o)); }
                  bnd = fminf(64.f * gq * gk * (0.125f * 1.4426950408889634f), 60.f); }
                f32x4 O[DIFF_MQ][8];
                {
                    bf16x8 Qf[DIFF_MQ][2];
#pragma unroll
                    for (int mq = 0; mq < DIFF_MQ; ++mq)
#pragma unroll
                        for (int kk = 0; kk < 2; ++kk) Qf[mq][kk] = *(const bf16x8*)(Qb + (size_t)(q0 + mq * 16 + lr) * DM + (2 * h) * 64 + kk * 32 + lg * 8);
                    attn_pass<64, 128, DIFF_MQ, false, true>(O, Qf, Kb + (size_t)s0 * DM + (2 * h) * 64, DM, VT + (size_t)s0 * DM + (size_t)(h * 128) * L, L, L, nullptr, bnd, smem);
#pragma unroll
                    for (int mq = 0; mq < DIFF_MQ; ++mq)
#pragma unroll
                        for (int kk = 0; kk < 2; ++kk) Qf[mq][kk] = *(const bf16x8*)(Qb + (size_t)(q0 + mq * 16 + lr) * DM + (2 * h + 1) * 64 + kk * 32 + lg * 8);
                    asm volatile("s_waitcnt vmcnt(0)" ::: "memory");
#pragma unroll
                    for (int mq = 0; mq < DIFF_MQ; ++mq)
#pragma unroll
                        for (int n = 0; n < 8; ++n) { uint2 v; v.x = pk2(O[mq][n][0], O[mq][n][1]); v.y = pk2(O[mq][n][2], O[mq][n][3]);
#if ATT_PIPE == 2
                            *(uint2*)(Qb + (size_t)(q0 + mq * 16 + lr) * DM + h * 128 + n * 16 + 4 * lg) = v; }
#else
                            *(uint2*)(smem + 49152 + ((w * DIFF_MQ + mq) * 8 + n) * 512 + lane * 8) = v; }
#endif
                    __syncthreads();
                    attn_pass<64, 128, DIFF_MQ, false, true>(O, Qf, Kb + (size_t)s0 * DM + (2 * h + 1) * 64, DM, VT + (size_t)s0 * DM + (size_t)(h * 128) * L, L, L, nullptr, bnd, smem);
                }
                float d1 = p.lq1[lane] * p.lk1[lane], d2 = p.lq2[lane] * p.lk2[lane];
#pragma unroll
                for (int o = 32; o > 0; o >>= 1) { d1 += __shfl_xor(d1, o); d2 += __shfl_xor(d2, o); }
                const float lam = expf(d1) - expf(d2) + 0.2f;
#pragma unroll
                for (int mq = 0; mq < DIFF_MQ; ++mq) {
                    float ss = 0.f;
#pragma unroll
                    for (int n = 0; n < 8; ++n) {
#if ATT_PIPE == 2
                        uint2 o1; { const unsigned long long ov = __hip_atomic_load((const unsigned long long*)(Qb + (size_t)(q0 + mq * 16 + lr) * DM + h * 128 + n * 16 + 4 * lg), __ATOMIC_RELAXED, __HIP_MEMORY_SCOPE_AGENT); o1.x = (unsigned)ov; o1.y = (unsigned)(ov >> 32); }
#else
                        const uint2 o1 = *(const uint2*)(smem + 49152 + ((w * DIFF_MQ + mq) * 8 + n) * 512 + lane * 8);
#endif
                        O[mq][n][0] = bflo(o1.x) - lam * O[mq][n][0]; O[mq][n][1] = bfhi(o1.x) - lam * O[mq][n][1];
                        O[mq][n][2] = bflo(o1.y) - lam * O[mq][n][2]; O[mq][n][3] = bfhi(o1.y) - lam * O[mq][n][3];
#pragma unroll
                        for (int j = 0; j < 4; ++j) ss += O[mq][n][j] * O[mq][n][j];
                    }
                    ss += __shfl_xor(ss, 16); ss += __shfl_xor(ss, 32);
                    const float sc = rsqrtf(ss * (1.f / 128.f) + EPS) * 0.8f;
                    bf16_t* dst = Qb + (size_t)(q0 + mq * 16 + lr) * DM + h * 128 + 4 * lg;
#pragma unroll
                    for (int n = 0; n < 8; ++n) { const f32x4 sg = *(const f32x4*)(p.sub_g + n * 16 + 4 * lg);
                        st4bf(dst + n * 16, O[mq][n][0] * sc * sg[0], O[mq][n][1] * sc * sg[1], O[mq][n][2] * sc * sg[2], O[mq][n][3] * sc * sg[3]); }
                }
            }
        }
        for (int it = bid; it < n_s5; it += nb) {
            PHASE_IDS
            {
                int g = it / ((NCH / BM) * 4), r = it % ((NCH / BM) * 4);
                if ((nb & 7) == 0 && n_s5 % nb == 0) {
                    const int lu = (it / nb) * (nb >> 3) + (bid >> 3); g = (lu / ((NCH / BM) * 4)) * 8 + (bid & 7); r = lu % ((NCH / BM) * 4); }
                const int ct = r >> 2, nt = r & 3;
                AS5 af{Ub, CAR, g};
                f32x4 acc[MT][4]; zero_acc<4>(acc);
                gemm_main<4, true>(acc, af, ct * BM, MTC + (size_t)g * 512 * 768, 768, nt * 128, 768, smem);
#pragma unroll
                for (int m = 0; m < MT; ++m) { const int chunk = ct * BM + wr * WM + m * 16 + lr;
#pragma unroll
                    for (int n = 0; n < 4; ++n) { const int ii = nt * 8 + wc * 4 + n; const size_t tok = (size_t)chunk * 32 + ii;
                        st4bf(Zb + tok * DM + g * 16 + 4 * lg, gelu_tanh(acc[m][n][0]), gelu_tanh(acc[m][n][1]), gelu_tanh(acc[m][n][2]), gelu_tanh(acc[m][n][3])); } }
            }
        }
        if (PM & 2) for (int it = bid; it < n_mem; it += nb) {
            PHASE_IDS
            {
                const int i2 = it, tq = i2 >> 2, head = i2 & 3;
                const int t0 = tq * (MEM_MQ * 64); int s0, L; seq_info(t0, s0, L);
                const int b = t0 < TP ? t0 / 2048 : 16 + (t0 - TP) / 4096;
                float bnd;
                { float gg = 0.f;
#pragma unroll
                  for (int e = 0; e < 4; ++e) gg = fmaxf(gg, fabsf(p.mem_q_g[lane * 4 + e] * p.mem_k_g[lane * 4 + e]));
#pragma unroll
                  for (int o = 32; o > 0; o >>= 1) gg = fmaxf(gg, __shfl_xor(gg, o));
                  bnd = fminf(256.f * gg * (0.0625f * 1.4426950408889634f), 60.f); }
                bf16x8 Qf[MEM_MQ][8];
#pragma unroll
                for (int mq = 0; mq < MEM_MQ; ++mq) {
                    const int qrow = t0 + w * (MEM_MQ * 16) + mq * 16 + lr;
                    uint4 raw[8]; float ss = 0.f;
#pragma unroll
                    for (int kk = 0; kk < 8; ++kk) { raw[kk] = *(const uint4*)(QM + (size_t)qrow * DM + head * 256 + kk * 32 + lg * 8);
                        const unsigned ww[4] = {raw[kk].x, raw[kk].y, raw[kk].z, raw[kk].w};
#pragma unroll
                        for (int e = 0; e < 4; ++e) { const float a = bflo(ww[e]), c = bfhi(ww[e]); ss += a * a + c * c; } }
                    ss += __shfl_xor(ss, 16); ss += __shfl_xor(ss, 32);
                    const float sc = rsqrtf(ss * (1.f / 256.f) + EPS) * (0.0625f * 1.4426950408889634f);
#pragma unroll
                    for (int kk = 0; kk < 8; ++kk) { const int d0 = kk * 32 + lg * 8;
                        const unsigned ww[4] = {raw[kk].x, raw[kk].y, raw[kk].z, raw[kk].w}; unsigned oo[4];
#pragma unroll
                        for (int e = 0; e < 4; ++e) { const int d = d0 + 2 * e;
                            oo[e] = pk2(bflo(ww[e]) * sc * p.mem_q_g[d] * p.mem_k_g[d], bfhi(ww[e]) * sc * p.mem_q_g[d + 1] * p.mem_k_g[d + 1]); }
                        uint4 pw; pw.x = oo[0]; pw.y = oo[1]; pw.z = oo[2]; pw.w = oo[3]; Qf[mq][kk] = *(bf16x8*)&pw; }
                }
                f32x4 O[MEM_MQ][16];
                attn_pass<256, 256, MEM_MQ, true, false>(O, Qf, MEMK + (size_t)(b * 256) * DM + head * 256, DM, MEMVT + ((size_t)b * 1024 + head * 256) * 256, 256, 256,
                                                    SSQK + head * 4 * 8192 + b * 256, bnd, smem);
#pragma unroll
                for (int mq = 0; mq < MEM_MQ; ++mq) {
                    bf16_t* dst = QM + (size_t)(t0 + w * (MEM_MQ * 16) + mq * 16 + lr) * DM + head * 256 + 4 * lg;
#pragma unroll
                    for (int n = 0; n < 16; ++n) st4bf(dst + n * 16, O[mq][n][0], O[mq][n][1], O[mq][n][2], O[mq][n][3]);
                }
            }
        }
    }
    GRID_SYNC();

    {
        const int n_glu = (TT / BM) * 8;
        for (int it = bid; it < n_glu + TT / 4; it += nb) {
            PHASE_IDS
            if (it < n_glu) {
                const int mt = (it >> 6) * 8 + (it & 7), nt = (it >> 3) & 7, row0 = mt * BM, n0 = nt * 128;
                APlain af{Zb, DM};
                f32x4 acc[MT][4]; zero_acc<4>(acc);
                gemm_main<4, true>(acc, af, row0, WT_GLU, DM, n0, DM, smem);
#pragma unroll
                for (int m = 0; m < MT; ++m) { const int row = row0 + wr * WM + m * 16 + lr;
#pragma unroll
                    for (int n = 0; n < 4; ++n) { const size_t o = (size_t)row * DM + n0 + wc * 64 + n * 16 + 4 * lg; const uint2 zz = *(const uint2*)(Zb + o);
                        st4bf(S5O + o, bflo(zz.x) * sigmoidf_(acc[m][n][0]), bfhi(zz.x) * sigmoidf_(acc[m][n][1]), bflo(zz.y) * sigmoidf_(acc[m][n][2]), bfhi(zz.y) * sigmoidf_(acc[m][n][3])); } }
            } else {
                const int t = (it - n_glu) * 4 + w; const float* src = t < TP ? p.x_p + (size_t)t * DM : p.x_s + (size_t)(t - TP) * DM; rms_row(src, p.norm_mix_g, HR + (size_t)t * DM, lane);
            }
        }
    }
    GRID_SYNC();

    if (PM & 8) for (int it = bid; it < (TT / BM) * 8; it += nb) {
        PHASE_IDS
        const int mt = (it >> 6) * 8 + (it & 7), nt = (it >> 3) & 7, row0 = mt * BM, n0 = nt * 128;
#pragma unroll 1
        for (int n3 = 0; n3 < 3; ++n3) {
            unsigned gpk[MT][4][2];
            {
                f32x4 ga[MT][4]; zero_acc<4>(ga);
                APlain af{HR, DM}; gemm_main_pf<4, true, 2>(ga, af, row0, WT_IN + (size_t)(5120 + n3 * 1024) * DM, DM, n0, DM, smem);
#pragma unroll
                for (int n = 0; n < 4; ++n) { const f32x4 bg = *(const f32x4*)(p.b_gate + n3 * 1024 + n0 + wc * 64 + n * 16 + 4 * lg);
#pragma unroll
                    for (int m = 0; m < MT; ++m) { gpk[m][n][0] = pk2(sigmoidf_(ga[m][n][0] + bg[0]), sigmoidf_(ga[m][n][1] + bg[1]));
                                                   gpk[m][n][1] = pk2(sigmoidf_(ga[m][n][2] + bg[2]), sigmoidf_(ga[m][n][3] + bg[3])); } }
            }
            f32x4 ba[MT][4]; zero_acc<4>(ba);
            { APlain af{n3 == 0 ? S5O : (n3 == 1 ? Qb : QM), DM}; gemm_main_pf<4, true, 2>(ba, af, row0, WT_BR + (size_t)n3 * 1024 * 1024, DM, n0, DM, smem); }
#pragma unroll
            for (int m = 0; m < MT; ++m) { const int row = row0 + wr * WM + m * 16 + lr;
#pragma unroll
                for (int n = 0; n < 4; ++n) {
                    unsigned long long* dst = (unsigned long long*)(MRG + (size_t)row * DM + n0 + wc * 64 + n * 16 + 4 * lg);
                    unsigned lo = 0u, hi = 0u;
                    if (n3 > 0) { const unsigned long long old = __hip_atomic_load(dst, __ATOMIC_RELAXED, __HIP_MEMORY_SCOPE_AGENT); lo = (unsigned)old; hi = (unsigned)(old >> 32); }
                    lo = pk2(fmaf(bflo(gpk[m][n][0]), ba[m][n][0], bflo(lo)), fmaf(bfhi(gpk[m][n][0]), ba[m][n][1], bfhi(lo)));
                    hi = pk2(fmaf(bflo(gpk[m][n][1]), ba[m][n][2], bflo(hi)), fmaf(bfhi(gpk[m][n][1]), ba[m][n][3], bfhi(hi)));
                    *dst = ((unsigned long long)hi << 32) | lo; } }
        }
    }
    GRID_SYNC();

    for (int it = bid; it < (TT / BM) * 8; it += nb) {
        PHASE_IDS
        const int mt = (it >> 6) * 8 + (it & 7), nt = (it >> 3) & 7, row0 = mt * BM, n0 = nt * 128;
        APlain af{MRG, DM};
        f32x4 acc[MT][4]; zero_acc<4>(acc);
        gemm_main<4, true>(acc, af, row0, WT_OUT, DM, n0, DM, smem);
#pragma unroll
        for (int m = 0; m < MT; ++m) { const int row = row0 + wr * WM + m * 16 + lr;
            const float* xr = row < TP ? p.x_p + (size_t)row * DM : p.x_s + (size_t)(row - TP) * DM;
#pragma unroll
            for (int n = 0; n < 4; ++n) { const int col = n0 + wc * 64 + n * 16 + 4 * lg; const f32x4 xv = *(const f32x4*)(xr + col);
                *(f32x4*)(p.out + (size_t)row * DM + col) = xv + acc[m][n]; } }
    }
    GRID_SYNC();

    for (int it = bid; it < TT / 4; it += nb) { PHASE_IDS const int t = it * 4 + w; rms_row(p.out + (size_t)t * DM, p.ffn_norm_g, H2 + (size_t)t * DM, lane); }
    GRID_SYNC();

#ifdef REP9
    for (int rep = 0; rep < REP9; ++rep)
#endif
    for (int it = bid; it < (TT / BM) * 44; it += nb) {
        PHASE_IDS
        const int mt = it / 44, jt = it % 44, row0 = mt * BM, n0 = jt * 128;
        APlain af{H2, DM};
        f32x4 acc[MT][4]; zero_acc<4>(acc);
        gemm_main<4, true>(acc, af, row0, WT_GU, DM, n0, DM, smem);
#pragma unroll
        for (int m = 0; m < MT; ++m) { const int row = row0 + wr * WM + m * 16 + lr;
#pragma unroll
            for (int pi = 0; pi < 2; ++pi) { const f32x4 gg = acc[m][2 * pi], uu = acc[m][2 * pi + 1];
                st4bf(ACT + (size_t)row * DFF + jt * 64 + wc * 32 + pi * 16 + 4 * lg, gg[0] * sigmoidf_(gg[0]) * uu[0], gg[1] * sigmoidf_(gg[1]) * uu[1], gg[2] * sigmoidf_(gg[2]) * uu[2], gg[3] * sigmoidf_(gg[3]) * uu[3]); } }
    }
    GRID_SYNC();

    for (int it = bid; it < (TT / BM) * 8; it += nb) {
        PHASE_IDS
        const int mt = (it >> 6) * 8 + (it & 7), nt = (it >> 3) & 7, row0 = mt * BM, n0 = nt * 128;
        APlain af{ACT, DFF};
        f32x4 acc[MT][4]; zero_acc<4>(acc);
        gemm_main_pf<4, true, 2>(acc, af, row0, WT_DN, DFF, n0, DFF, smem);
#pragma unroll
        for (int m = 0; m < MT; ++m) { const int row = row0 + wr * WM + m * 16 + lr;
#pragma unroll
            for (int n = 0; n < 4; ++n) { float* o = p.out + (size_t)row * DM + n0 + wc * 64 + n * 16 + 4 * lg; const f32x4 xv = *(const f32x4*)o; *(f32x4*)o = xv + acc[m][n]; } }
    }
}

extern "C" void kernel_launch(void* const* d_in, const int* in_sizes, int n_in, void* d_out, int out_size, void* d_ws, size_t ws_size, hipStream_t stream) {
    static int grid_blocks = 0;
    if (!grid_blocks) {
        int dev = 0, cus = 0, per_cu = 0;
        hipGetDevice(&dev);
        hipDeviceGetAttribute(&cus, hipDeviceAttributeMultiprocessorCount, dev);
        hipFuncSetAttribute((const void*)fwd_megakernel, hipFuncAttributeMaxDynamicSharedMemorySize, LDS_BYTES);
        hipOccupancyMaxActiveBlocksPerMultiprocessor(&per_cu, fwd_megakernel, 256, LDS_BYTES);
        if (per_cu > 2) per_cu = 2;
        if (per_cu < 1) per_cu = 1;
        grid_blocks = cus * per_cu;
    }
    if (ws_size < OFF_END) { fprintf(stderr, "workspace too small: %zu\n", ws_size); return; }
    Params p{};
    const float* const* in = (const float* const*)d_in;
    p.x_p = in[0]; p.x_s = in[1]; p.mem_p = in[2]; p.mem_s = in[3]; p.norm_mix_g = in[4]; p.w_in = in[5]; p.b_gate = in[6];
    p.lam_re = in[7]; p.lam_im = in[8]; p.log_dt = in[9]; p.b_re = in[10]; p.b_im = in[11]; p.c_re = in[12]; p.c_im = in[13];
    p.s5_d = in[14]; p.w_glu = in[15]; p.q_g = in[16]; p.k_g = in[17]; p.lq1 = in[18]; p.lk1 = in[19]; p.lq2 = in[20]; p.lk2 = in[21]; p.sub_g = in[22];
    p.mem_norm_g = in[23]; p.w_mkv = in[24]; p.mem_q_g = in[25]; p.mem_k_g = in[26]; p.w_branch = in[27]; p.w_out = in[28]; p.ffn_norm_g = in[29];
    p.w_gu = in[30]; p.w_dn = in[31];
    p.out = (float*)d_out; p.ws = (char*)d_ws;
    void* args[] = {&p};
    hipError_t e = hipLaunchCooperativeKernel((void*)fwd_megakernel, dim3(grid_blocks), dim3(256), args, LDS_BYTES, stream);
    if (e != hipSuccess) fprintf(stderr, "cooperative launch failed: %s (grid %d)\n", hipGetErrorString(e), grid_blocks);
}
```

```cpp
#include <hip/hip_runtime.h>
#include <hip/hip_cooperative_groups.h>
#include <cstdio>
#include <cstdint>
namespace cg = cooperative_groups;
#ifndef ATT_PIPE
#define ATT_PIPE 2
#endif
#ifndef GEMM_PF
#define GEMM_PF 3
#endif

typedef unsigned short bf16_t;
typedef short bf16x8 __attribute__((ext_vector_type(8)));
typedef float f32x4 __attribute__((ext_vector_type(4)));
typedef unsigned u32x4 __attribute__((ext_vector_type(4)));

constexpr int DM = 1024;
constexpr int TP = 16 * 2048, TS = 16 * 4096, TT = TP + TS;
constexpr int NCH = TT / 32;
constexpr int DFF = 2816;
constexpr float EPS = 1e-6f;
constexpr size_t MiB = 1024ull * 1024ull;
constexpr int MT = 4, BM = 32 * MT, WM = 16 * MT;
constexpr int LDS_BYTES = 81920;

constexpr size_t OFF_WT_IN = 0, OFF_WT_GLU = 16 * MiB, OFF_WT_MKV = 18 * MiB, OFF_WT_BR = 22 * MiB, OFF_WT_OUT = 28 * MiB,
                 OFF_WT_GU = 30 * MiB, OFF_WT_DN = 41 * MiB, OFF_ROPE = 46 * MiB + 512 * 1024, OFF_SSQK = 47 * MiB + 512 * 1024,
                 OFF_MEMN = 48 * MiB, OFF_MEMK = 64 * MiB, OFF_MEMVT = 80 * MiB, OFF_H = 96 * MiB, OFF_U = 288 * MiB, OFF_Q = 480 * MiB,
                 OFF_K = 672 * MiB, OFF_MA = 864 * MiB, OFF_MTC = 880 * MiB, OFF_CAR = 928 * MiB, OFF_END = 1024 * MiB;
constexpr size_t OFF_KC = OFF_CAR;
constexpr size_t OFF_Z = OFF_H;
constexpr size_t OFF_S5OUT = OFF_U;
constexpr size_t OFF_MERGED = OFF_K;
constexpr size_t OFF_ACT = OFF_H;
constexpr size_t OFF_H2 = OFF_K;
constexpr size_t DOFF_QM = 0, DOFF_VT = 192 * MiB;

struct Params {
    const float* x_p; const float* x_s; const float* mem_p; const float* mem_s;
    const float* norm_mix_g; const float* w_in; const float* b_gate;
    const float* lam_re; const float* lam_im; const float* log_dt; const float* b_re; const float* b_im; const float* c_re; const float* c_im;
    const float* s5_d; const float* w_glu;
    const float* q_g; const float* k_g; const float* lq1; const float* lk1; const float* lq2; const float* lk2; const float* sub_g;
    const float* mem_norm_g; const float* w_mkv; const float* mem_q_g; const float* mem_k_g;
    const float* w_branch; const float* w_out; const float* ffn_norm_g; const float* w_gu; const float* w_dn;
    float* out; char* ws;
};

typedef __bf16 bf16v2_t __attribute__((ext_vector_type(2)));
typedef float f32v2_t __attribute__((ext_vector_type(2)));
__device__ __forceinline__ unsigned pk2(float lo, float hi) { f32v2_t v = {lo, hi}; bf16v2_t b = __builtin_convertvector(v, bf16v2_t); return __builtin_bit_cast(unsigned, b); }
__device__ __forceinline__ float bf2f(unsigned short v) { return __uint_as_float(((unsigned)v) << 16); }
__device__ __forceinline__ float bflo(unsigned v) { return __uint_as_float(v << 16); }
__device__ __forceinline__ float bfhi(unsigned v) { return __uint_as_float(v & 0xffff0000u); }
__device__ __forceinline__ void st4bf(bf16_t* p, float a, float b, float c, float d) { uint2 v; v.x = pk2(a, b); v.y = pk2(c, d); *(uint2*)p = v; }
__device__ __forceinline__ float sigmoidf_(float x) { return 1.f / (1.f + __expf(-x)); }
__device__ __forceinline__ float gelu_tanh(float y) { float a = 0.7978845608028654f * (y + 0.044715f * y * y * y); float e = __expf(2.f * a); float t = 1.f - 2.f / (e + 1.f); return 0.5f * y * (1.f + t); }
__device__ __forceinline__ void seq_info(int t, int& s0, int& L) { if (t < TP) { L = 2048; s0 = t & ~2047; } else { L = 4096; s0 = TP + ((t - TP) & ~4095); } }
__device__ __forceinline__ int opaque_tid() { int t = threadIdx.x; asm volatile("" : "+v"(t)); return t; }
#define PHASE_IDS const int tid = opaque_tid(), lane = tid & 63, w = tid >> 6, wr = w >> 1, wc = w & 1, lr = lane & 15, lg = lane >> 4; (void)wr; (void)wc; (void)lr; (void)lg; (void)w; (void)lane;
#define MFMA16(a, b, c) __builtin_amdgcn_mfma_f32_16x16x32_bf16((a), (b), (c), 0, 0, 0)

struct APlain { const bf16_t* A; int lda; __device__ __forceinline__ const bf16_t* operator()(int row, int k) const { return A + (size_t)row * lda + k; } };
struct AS5 { const bf16_t* U; const bf16_t* CAR; int g;
    __device__ __forceinline__ const bf16_t* operator()(int chunk, int k) const {
        return k < 512 ? U + ((size_t)g * NCH + chunk) * 512 + k : CAR + ((size_t)g * NCH + chunk) * 256 + (k - 512); } };

template <int NT, bool SWAP, int PF, class AF>
__device__ __forceinline__ void gemm_main_pf(f32x4 (&acc)[MT][NT], const AF& af, int row0, const bf16_t* __restrict__ Bt, int ldb, int n0, int K, char* lds) {
    const int tid = opaque_tid(), lane = tid & 63, w = tid >> 6, wr = w >> 1, wc = w & 1, lr = lane & 15, lg = lane >> 4;
    constexpr int NB = NT;
    constexpr int AB = BM * 128, STG = (BM + NT * 32) * 128;
    const int ldr = tid >> 3, ldc = tid & 7;
    const int swz = ((ldc ^ (ldr & 7)) << 4);
    u32x4 ra0[MT], rb0[NB], ra1[MT], rb1[NB];
    const int nk = K >> 6;
#define GM_GLOAD(RA, RB, KT) { const int k_ = (KT) * 64 + ldc * 8; _Pragma("unroll") for (int i = 0; i < MT; ++i) RA[i] = *(const u32x4*)af(row0 + ldr + 32 * i, k_); \
                       _Pragma("unroll") for (int i = 0; i < NB; ++i) RB[i] = *(const u32x4*)(Bt + (size_t)(n0 + ldr + 32 * i) * ldb + k_); }
#define GM_LSTORE(RA, RB, ST_) { char* base_ = lds + (ST_) * STG; _Pragma("unroll") for (int i = 0; i < MT; ++i) *(u32x4*)(base_ + (ldr + 32 * i) * 128 + swz) = RA[i]; \
                       _Pragma("unroll") for (int i = 0; i < NB; ++i) *(u32x4*)(base_ + AB + (ldr + 32 * i) * 128 + swz) = RB[i]; }
#define GM_COMPUTE(ST_) { const char* base = lds + (ST_) * STG; \
        _Pragma("unroll") for (int kk = 0; kk < 2; ++kk) { \
            bf16x8 fa[MT], fb[NT]; \
            const int co = (((kk * 4 + lg) ^ (lr & 7)) << 4); \
            _Pragma("unroll") for (int m = 0; m < MT; ++m) fa[m] = *(const bf16x8*)(base + (wr * WM + m * 16 + lr) * 128 + co); \
            _Pragma("unroll") for (int n = 0; n < NT; ++n) fb[n] = *(const bf16x8*)(base + AB + (wc * (NT * 16) + n * 16 + lr) * 128 + co); \
            _Pragma("unroll") for (int m = 0; m < MT; ++m) _Pragma("unroll") for (int n = 0; n < NT; ++n) acc[m][n] = SWAP ? MFMA16(fb[n], fa[m], acc[m][n]) : MFMA16(fa[m], fb[n], acc[m][n]); } }
    if constexpr (PF == 2) {
    GM_GLOAD(ra0, rb0, 0); GM_LSTORE(ra0, rb0, 0); GM_GLOAD(ra1, rb1, 1); __syncthreads();
    for (int kt = 0; kt < nk; kt += 2) {
        { const int k2 = kt + 2 < nk ? kt + 2 : nk - 1; GM_GLOAD(ra0, rb0, k2); }
        GM_COMPUTE(0);
        GM_LSTORE(ra1, rb1, 1);
        __syncthreads();
        { const int k3 = kt + 3 < nk ? kt + 3 : nk - 1; GM_GLOAD(ra1, rb1, k3); }
        GM_COMPUTE(1);
        if (kt + 2 < nk) GM_LSTORE(ra0, rb0, 0);
        __syncthreads();
    }
    } else if constexpr (PF == 3) {
    u32x4 ra2[MT], rb2[NB];
    GM_GLOAD(ra0, rb0, 0); GM_LSTORE(ra0, rb0, 0); GM_GLOAD(ra1, rb1, 1); { const int k2 = 2 < nk ? 2 : nk - 1; GM_GLOAD(ra2, rb2, k2); } __syncthreads();
#define GM_STEP(KT, RL_A, RL_B, RS_A, RS_B) { const int kt_ = (KT); \
        { const int k3 = kt_ + 3 < nk ? kt_ + 3 : nk - 1; GM_GLOAD(RL_A, RL_B, k3); } \
        GM_COMPUTE(kt_ & 1); \
        if (kt_ + 1 < nk) GM_LSTORE(RS_A, RS_B, (kt_ + 1) & 1); \
        __syncthreads(); }
    for (int kt = 0; kt < nk; kt += 3) {
        GM_STEP(kt, ra0, rb0, ra1, rb1);
        if (kt + 1 >= nk) break;
        GM_STEP(kt + 1, ra1, rb1, ra2, rb2);
        if (kt + 2 >= nk) break;
        GM_STEP(kt + 2, ra2, rb2, ra0, rb0);
    }
    } else {
    GM_GLOAD(ra0, rb0, 0); GM_LSTORE(ra0, rb0, 0); __syncthreads();
    for (int kt = 0; kt < nk; kt += 2) {
        GM_GLOAD(ra0, rb0, kt + 1);
        GM_COMPUTE(0);
        GM_LSTORE(ra0, rb0, 1);
        __syncthreads();
        { const int k2 = kt + 2 < nk ? kt + 2 : nk - 1; GM_GLOAD(ra0, rb0, k2); }
        GM_COMPUTE(1);
        if (kt + 2 < nk) GM_LSTORE(ra0, rb0, 0);
        __syncthreads();
    }
    }
}
template <int NT, bool SWAP, class AF>
__device__ __forceinline__ void gemm_main(f32x4 (&acc)[MT][NT], const AF& af, int row0, const bf16_t* __restrict__ Bt, int ldb, int n0, int K, char* lds) {
    __builtin_amdgcn_s_setprio(1);
    gemm_main_pf<NT, SWAP, (NT == 4 ? GEMM_PF : 2)>(acc, af, row0, Bt, ldb, n0, K, lds);
    __builtin_amdgcn_s_setprio(0);
}
template <int NT> __device__ __forceinline__ void zero_acc(f32x4 (&acc)[MT][NT]) {
#pragma unroll
    for (int m = 0; m < MT; ++m)
#pragma unroll
        for (int n = 0; n < NT; ++n) acc[m][n] = (f32x4){0.f, 0.f, 0.f, 0.f};
}

__device__ __forceinline__ void wait_vm6() { asm volatile("s_waitcnt vmcnt(6)" ::: "memory"); }
__device__ __forceinline__ void wait_vm0() { asm volatile("s_waitcnt vmcnt(0)" ::: "memory"); }
template <int DH> __device__ __forceinline__ int kswz(int row, int c) { return DH == 64 ? row * 128 + ((c ^ (row & 7)) << 4) : row * 512 + ((c ^ (row & 15)) << 4); }
template <int DH, int E, int MQ, bool KSC, bool DB>
__device__ __forceinline__ void attn_pass(f32x4 (&O)[MQ][E / 16], const bf16x8 (&Qf)[MQ][DH / 32], const bf16_t* __restrict__ Kp, int ldk,
                                          const bf16_t* __restrict__ Vt, int ldv, int nkeys, const float* __restrict__ ksq, float bnd, char* lds) {
    constexpr int KB = 64 * DH * 2, VB = E * 128, ST = KB + VB, KC = DH / 8, NKL = 64 * KC / 256, NVL = E * 8 / 256;
    const int tid = opaque_tid(), lane = tid & 63, lr = lane & 15, lg = lane >> 4;
    float lsum[MQ];
#pragma unroll
    for (int q = 0; q < MQ; ++q) { lsum[q] = 0.f;
#pragma unroll
        for (int n = 0; n < E / 16; ++n) O[q][n] = (f32x4){0.f, 0.f, 0.f, 0.f}; }
    u32x4 rk[NKL], rv[NVL];
#define GLOADK(T) { const int key0_ = (T) * 64; _Pragma("unroll") for (int i = 0; i < NKL; ++i) { const int q = tid + 256 * i, r = q / KC, c = q % KC; rk[i] = *(const u32x4*)(Kp + (size_t)(key0_ + r) * ldk + c * 8); } }
#define GLOADV(T) { const int key0_ = (T) * 64; _Pragma("unroll") for (int i = 0; i < NVL; ++i) { const int q = tid + 256 * i, e = q >> 3, c = q & 7; rv[i] = *(const u32x4*)(Vt + (size_t)e * ldv + key0_ + c * 8); } }
#define LSTOREK(STG) { char* base_ = lds + (STG) * ST; _Pragma("unroll") for (int i = 0; i < NKL; ++i) { const int q = tid + 256 * i, r = q / KC, c = q % KC; *(u32x4*)(base_ + kswz<DH>(r, c)) = rk[i]; } }
#define LSTOREV(STG) { char* base_ = lds + (STG) * ST; _Pragma("unroll") for (int i = 0; i < NVL; ++i) { const int q = tid + 256 * i, e = q >> 3, c = q & 7; *(u32x4*)(base_ + KB + e * 128 + ((c ^ ((e >> 1) & 7)) << 4)) = rv[i]; } }
#define ATT_QK(S_, BASE_, SINIT_) { \
        _Pragma("unroll") for (int q = 0; q < MQ; ++q) _Pragma("unroll") for (int k4 = 0; k4 < 4; ++k4) S_[q][k4] = (f32x4){SINIT_, SINIT_, SINIT_, SINIT_}; \
        _Pragma("unroll") for (int k4 = 0; k4 < 4; ++k4) _Pragma("unroll") for (int kk = 0; kk < DH / 32; ++kk) { \
            const bf16x8 kf = *(const bf16x8*)((BASE_) + kswz<DH>(k4 * 16 + lr, kk * 4 + lg)); \
            __builtin_amdgcn_s_setprio(1); _Pragma("unroll") for (int q = 0; q < MQ; ++q) S_[q][k4] = MFMA16(kf, Qf[q][kk], S_[q][k4]); __builtin_amdgcn_s_setprio(0); } }
#define ATT_SOFTMAX(S_) { \
        _Pragma("unroll") for (int q = 0; q < MQ; ++q) { float ps = 0.f; \
            _Pragma("unroll") for (int k4 = 0; k4 < 4; ++k4) _Pragma("unroll") for (int j = 0; j < 4; ++j) { const float pv = __builtin_amdgcn_exp2f(S_[q][k4][j]); S_[q][k4][j] = pv; ps += pv; } \
            lsum[q] += ps; \
            _Pragma("unroll") for (int k2 = 0; k2 < 2; ++k2) { uint4 pw; pw.x = pk2(S_[q][2 * k2][0], S_[q][2 * k2][1]); pw.y = pk2(S_[q][2 * k2][2], S_[q][2 * k2][3]); \
                pw.z = pk2(S_[q][2 * k2 + 1][0], S_[q][2 * k2 + 1][1]); pw.w = pk2(S_[q][2 * k2 + 1][2], S_[q][2 * k2 + 1][3]); Pf[q][k2] = *(bf16x8*)&pw; } } }
#define ATT_PV(BASE_) { \
        _Pragma("unroll") for (int k2 = 0; k2 < 2; ++k2) _Pragma("unroll") for (int n = 0; n < E / 16; ++n) { \
            const char* rowp = (BASE_) + KB + n * 2048; \
            uint4 vw; const uint2 v0 = *(const uint2*)(rowp + (k2 == 0 ? vo00 : vo10)), v1 = *(const uint2*)(rowp + (k2 == 0 ? vo01 : vo11)); \
            vw.x = v0.x; vw.y = v0.y; vw.z = v1.x; vw.w = v1.y; const bf16x8 vf = *(bf16x8*)&vw; \
            __builtin_amdgcn_s_setprio(1); _Pragma("unroll") for (int q = 0; q < MQ; ++q) O[q][n] = MFMA16(vf, Pf[q][k2], O[q][n]); __builtin_amdgcn_s_setprio(0); } }
    const int vsw = (lr >> 1) & 7;
    const int vo00 = lr * 128 + (lg & 1) * 8 + ((((lg >> 1)) ^ vsw) << 4), vo01 = lr * 128 + (lg & 1) * 8 + ((((lg >> 1) + 2) ^ vsw) << 4);
    const int vo10 = lr * 128 + (lg & 1) * 8 + (((4 + (lg >> 1)) ^ vsw) << 4), vo11 = lr * 128 + (lg & 1) * 8 + (((6 + (lg >> 1)) ^ vsw) << 4);
    const int nt = nkeys >> 6;
    bf16x8 Pf[MQ][2];
#if ATT_PIPE == 2
    if (DB) {
        const float sinit = -bnd;
        f32x4 Sc[MQ][4];
#define ATT_ISSUE(T, STG) { const int key0_ = (T) * 64; char* sb_ = lds + (STG) * ST + tid * 16; \
        _Pragma("unroll") for (int i = 0; i < NKL; ++i) { const int L_ = tid + 256 * i, r = L_ / KC, c = (L_ % KC) ^ (r & 7); \
            __builtin_amdgcn_global_load_lds((const unsigned*)(Kp + (size_t)(key0_ + r) * ldk + c * 8), (__attribute__((address_space(3))) unsigned*)(sb_ + i * 4096), 16, 0, 0); } \
        _Pragma("unroll") for (int i = 0; i < NVL; ++i) { const int L_ = tid + 256 * i, e = L_ >> 3, c = (L_ & 7) ^ ((e >> 1) & 7); \
            __builtin_amdgcn_global_load_lds((const unsigned*)(Vt + (size_t)e * ldv + key0_ + c * 8), (__attribute__((address_space(3))) unsigned*)(sb_ + KB + i * 4096), 16, 0, 0); } }
        static_assert(!DB || (DH == 64 && NKL + NVL == 6), "glds attention path is written for DH = 64, E = 128");
        ATT_ISSUE(0, 0); ATT_ISSUE(1, 1);
        wait_vm6(); __builtin_amdgcn_s_barrier(); asm volatile("" ::: "memory");
        int st = 0;
        for (int t = 0; t < nt; ++t) {
            const int st2 = st == 0 ? 2 : st - 1;
            if (t + 2 < nt) ATT_ISSUE(t + 2, st2);
            ATT_QK(Sc, lds + st * ST, sinit);
            ATT_SOFTMAX(Sc);
            ATT_PV(lds + st * ST);
            if (t + 2 < nt) wait_vm6(); else wait_vm0();
            __builtin_amdgcn_s_barrier(); asm volatile("" ::: "memory");
            st = st == 2 ? 0 : st + 1;
        }
    } else
#elif !ATT_PIPE
    if (DB) {
        const float sinit = -bnd;
        f32x4 Sc[MQ][4];
        GLOADK(0); GLOADV(0); LSTOREK(0); LSTOREV(0); __syncthreads();
        for (int t = 0; t < nt; ++t) {
            { const int t1_ = t + 1 < nt ? t + 1 : nt - 1; GLOADK(t1_); GLOADV(t1_); }
            ATT_QK(Sc, lds + (t & 1) * ST, sinit);
            ATT_SOFTMAX(Sc);
            ATT_PV(lds + (t & 1) * ST);
            if (t + 1 < nt) { LSTOREK((t + 1) & 1); LSTOREV((t + 1) & 1); }
            __syncthreads();
        }
    } else
#endif
    if (DB) {
        const float sinit = -bnd;
        f32x4 Sc[MQ][4], Sn[MQ][4];
        GLOADK(0); GLOADV(0); LSTOREK(0); LSTOREV(0); __syncthreads();
        { const int t1_ = nt > 1 ? 1 : 0; GLOADK(t1_); GLOADV(t1_); }
        ATT_QK(Sc, lds, sinit);
        for (int t = 0; t < nt; ++t) {
            __syncthreads();
            if (t + 1 < nt) { LSTOREK((t + 1) & 1); LSTOREV((t + 1) & 1); }
            __syncthreads();
            { const int t2_ = t + 2 < nt ? t + 2 : nt - 1; GLOADK(t2_); GLOADV(t2_); }
            if (t + 1 < nt) ATT_QK(Sn, lds + ((t + 1) & 1) * ST, sinit);
            ATT_SOFTMAX(Sc);
            ATT_PV(lds + (t & 1) * ST);
#pragma unroll
            for (int q = 0; q < MQ; ++q)
#pragma unroll
                for (int k4 = 0; k4 < 4; ++k4) Sc[q][k4] = Sn[q][k4];
        }
        __syncthreads();
    } else {
        GLOADK(0); LSTOREK(0); GLOADV(0); LSTOREV(0); __syncthreads();
        for (int t = 0; t < nt; ++t) {
            f32x4 Sc[MQ][4];
            ATT_QK(Sc, lds, 0.f);
            if (KSC) {
#pragma unroll
                for (int k4 = 0; k4 < 4; ++k4) {
                    float4 sq = *(const float4*)(ksq + t * 64 + k4 * 16 + 4 * lg);
#pragma unroll
                    for (int pt = 1; pt < 4; ++pt) { const float4 s2 = *(const float4*)(ksq + pt * 8192 + t * 64 + k4 * 16 + 4 * lg); sq.x += s2.x; sq.y += s2.y; sq.z += s2.z; sq.w += s2.w; }
                    const float s0 = rsqrtf(sq.x * (1.f / 256.f) + EPS), s1 = rsqrtf(sq.y * (1.f / 256.f) + EPS), s2 = rsqrtf(sq.z * (1.f / 256.f) + EPS), s3 = rsqrtf(sq.w * (1.f / 256.f) + EPS);
#pragma unroll
                    for (int q = 0; q < MQ; ++q) { Sc[q][k4][0] = fmaf(Sc[q][k4][0], s0, -bnd); Sc[q][k4][1] = fmaf(Sc[q][k4][1], s1, -bnd); Sc[q][k4][2] = fmaf(Sc[q][k4][2], s2, -bnd); Sc[q][k4][3] = fmaf(Sc[q][k4][3], s3, -bnd); }
                }
            } else {
#pragma unroll
                for (int q = 0; q < MQ; ++q)
#pragma unroll
                    for (int k4 = 0; k4 < 4; ++k4) Sc[q][k4] -= bnd;
            }
            ATT_SOFTMAX(Sc);
            ATT_PV(lds);
            __syncthreads();
            if (t + 1 < nt) { GLOADK(t + 1); LSTOREK(0); GLOADV(t + 1); LSTOREV(0); __syncthreads(); }
        }
    }
#pragma unroll
    for (int q = 0; q < MQ; ++q) {
        float l = lsum[q]; l += __shfl_xor(l, 16); l += __shfl_xor(l, 32);
        const float inv = 1.f / l;
#pragma unroll
        for (int n = 0; n < E / 16; ++n) O[q][n] *= inv;
    }
}

__device__ __forceinline__ void rms_row(const float* __restrict__ src, const float* __restrict__ g, bf16_t* __restrict__ dst, int lane) {
    float4 v[4]; float ss = 0.f;
#pragma unroll
    for (int i = 0; i < 4; ++i) { v[i] = *(const float4*)(src + (i * 64 + lane) * 4); ss += v[i].x * v[i].x + v[i].y * v[i].y + v[i].z * v[i].z + v[i].w * v[i].w; }
#pragma unroll
    for (int o = 32; o > 0; o >>= 1) ss += __shfl_xor(ss, o);
    const float rstd = rsqrtf(ss * (1.f / 1024.f) + EPS);
#pragma unroll
    for (int i = 0; i < 4; ++i) { const float4 gg = *(const float4*)(g + (i * 64 + lane) * 4);
        st4bf(dst + (i * 64 + lane) * 4, v[i].x * rstd * gg.x, v[i].y * rstd * gg.y, v[i].z * rstd * gg.z, v[i].w * rstd * gg.w); }
}

template <bool PERM_GU>
__device__ __forceinline__ void transpose_w(const float* __restrict__ src, int K, int N, bf16_t* __restrict__ dst, char* lds) {
    float* T = (float*)lds;
    const int tid = opaque_tid(), tk = K / 64, tn = N / 64;
    for (int t = blockIdx.x; t < tk * tn; t += gridDim.x) {
        const int k0 = (t / tn) * 64, n0 = (t % tn) * 64;
#pragma unroll
        for (int i = 0; i < 16; ++i) { const int kr = (tid >> 6) + 4 * i, nc = tid & 63; T[kr * 65 + nc] = src[(size_t)(k0 + kr) * N + n0 + nc]; }
        __syncthreads();
        const int nl = tid >> 2, ks = (tid & 3) * 16;
        int n = n0 + nl;
        if (PERM_GU) { const int isup = n >= DFF ? 1 : 0; const int c = n - isup * DFF; n = (c >> 6) * 128 + ((c >> 5) & 1) * 64 + (((c >> 4) & 1) * 2 + isup) * 16 + (c & 15); }
        uint4 o0, o1;
        o0.x = pk2(T[(ks + 0) * 65 + nl], T[(ks + 1) * 65 + nl]); o0.y = pk2(T[(ks + 2) * 65 + nl], T[(ks + 3) * 65 + nl]);
        o0.z = pk2(T[(ks + 4) * 65 + nl], T[(ks + 5) * 65 + nl]); o0.w = pk2(T[(ks + 6) * 65 + nl], T[(ks + 7) * 65 + nl]);
        o1.x = pk2(T[(ks + 8) * 65 + nl], T[(ks + 9) * 65 + nl]); o1.y = pk2(T[(ks + 10) * 65 + nl], T[(ks + 11) * 65 + nl]);
        o1.z = pk2(T[(ks + 12) * 65 + nl], T[(ks + 13) * 65 + nl]); o1.w = pk2(T[(ks + 14) * 65 + nl], T[(ks + 15) * 65 + nl]);
        bf16_t* d = dst + (size_t)n * K + k0 + ks;
        *(uint4*)d = o0; *(uint4*)(d + 8) = o1;
        __syncthreads();
    }
}

__device__ __forceinline__ float2 cmul(float2 a, float2 b) { return make_float2(a.x * b.x - a.y * b.y, a.x * b.y + a.y * b.x); }
__device__ __forceinline__ void s5_prep(const Params& p, int g, int dir, char* lds) {
    float2* POW = (float2*)lds;
    float2* BB = POW + 33 * 64;
    float2* CC = BB + 64 * 16;
    float2* COEF = CC + 16 * 64;
    const int tid = opaque_tid();
    const int gd = dir * 64 + g;
    if (tid < 64) {
        const int pp = tid;
        const float lre = p.lam_re[gd * 64 + pp], lim = p.lam_im[gd * 64 + pp];
        const float dt = expf(p.log_dt[gd]);
        for (int d = 0; d <= 32; ++d) { const float mag = expf((float)d * lre * dt); float sn, cs; sincosf((float)d * lim * dt, &sn, &cs); POW[d * 64 + pp] = make_float2(mag * cs, mag * sn); }
        const float a = lre * dt, b = lim * dt; float sn, cs, sh, ch; sincosf(b, &sn, &cs); sincosf(0.5f * b, &sh, &ch);
        const float nr = expm1f(a) * cs - 2.f * sh * sh, ni = expf(a) * sn;
        const float den = 1.f / (lre * lre + lim * lim);
        COEF[pp] = make_float2((nr * lre + ni * lim) * den, (ni * lre - nr * lim) * den);
    }
    __syncthreads();
    for (int i = tid; i < 1024; i += 256) {
        const int pp = i >> 4, h = i & 15;
        BB[i] = cmul(COEF[pp], make_float2(p.b_re[(gd * 64 + pp) * 16 + h], p.b_im[(gd * 64 + pp) * 16 + h]));
        const int hh = i >> 6, p2 = i & 63;
        CC[i] = make_float2(p.c_re[(gd * 16 + hh) * 64 + p2], p.c_im[(gd * 16 + hh) * 64 + p2]);
    }
    __syncthreads();
    float* Kc = (float*)(p.ws + OFF_KC) + (size_t)(g * 2 + dir) * 32 * 256;
    { const int hp = tid >> 4, h = tid & 15;
      float sacc[32];
#pragma unroll
      for (int d = 0; d < 32; ++d) sacc[d] = 0.f;
#pragma unroll 1
      for (int pp = 0; pp < 64; ++pp) { const float2 wcb = cmul(CC[hp * 64 + pp], BB[pp * 16 + h]);
#pragma unroll
          for (int d = 0; d < 32; ++d) { const float2 pw = POW[d * 64 + pp]; sacc[d] += wcb.x * pw.x - wcb.y * pw.y; } }
#pragma unroll
      for (int d = 0; d < 32; ++d) Kc[d * 256 + tid] = sacc[d]; }
    bf16_t* MA = (bf16_t*)(p.ws + OFF_MA) + ((size_t)g * 256 + dir * 128) * 512;
    for (int i = tid; i < 128 * 512; i += 256) {
        const int k = i & 511, nl = i >> 9, pp = nl >> 1, c = nl & 1, j = k >> 4, h = k & 15;
        const float2 w = cmul(POW[(dir == 0 ? 31 - j : j) * 64 + pp], BB[pp * 16 + h]);
        const float v = c == 0 ? w.x : w.y;
        MA[(size_t)nl * 512 + k] = (bf16_t)(pk2(v, 0.f) & 0xffff);
    }
    bf16_t* MTC = (bf16_t*)(p.ws + OFF_MTC) + (size_t)g * 512 * 768 + 512 + dir * 128;
    for (int i = tid; i < 512 * 128; i += 256) {
        const int cl = i & 127, row = i >> 7, pp = cl >> 1, c = cl & 1, ii = row >> 4, hp = row & 15;
        const float2 w = cmul(CC[hp * 64 + pp], POW[(dir == 0 ? ii + 1 : 32 - ii) * 64 + pp]);
        const float v = c == 0 ? w.x : -w.y;
        MTC[(size_t)row * 768 + cl] = (bf16_t)(pk2(v, 0.f) & 0xffff);
    }
    __syncthreads();
}

#ifndef DIFF_MQ
#define DIFF_MQ 2
#endif
#ifndef MEM_MQ
#define MEM_MQ 1
#endif
#ifndef PM
#define PM 0xffff
#endif
#define GRID_SYNC() do { asm volatile("s_waitcnt vmcnt(0)" ::: "memory"); grid.sync(); } while (0)
__global__ void __launch_bounds__(256, 2) fwd_megakernel(Params p) {
    cg::grid_group grid = cg::this_grid();
    extern __shared__ __attribute__((aligned(16))) char smem[];
    const int nb = gridDim.x, bid = blockIdx.x;
    char* ws = p.ws;
    bf16_t* WT_IN = (bf16_t*)(ws + OFF_WT_IN); bf16_t* WT_GLU = (bf16_t*)(ws + OFF_WT_GLU); bf16_t* WT_MKV = (bf16_t*)(ws + OFF_WT_MKV);
    bf16_t* WT_BR = (bf16_t*)(ws + OFF_WT_BR); bf16_t* WT_OUT = (bf16_t*)(ws + OFF_WT_OUT); bf16_t* WT_GU = (bf16_t*)(ws + OFF_WT_GU); bf16_t* WT_DN = (bf16_t*)(ws + OFF_WT_DN);
    float* ROPE = (float*)(ws + OFF_ROPE); float* SSQK = (float*)(ws + OFF_SSQK);
    bf16_t* MEMN = (bf16_t*)(ws + OFF_MEMN); bf16_t* MEMK = (bf16_t*)(ws + OFF_MEMK); bf16_t* MEMVT = (bf16_t*)(ws + OFF_MEMVT);
    bf16_t* Hh = (bf16_t*)(ws + OFF_H); bf16_t* Ub = (bf16_t*)(ws + OFF_U); bf16_t* Qb = (bf16_t*)(ws + OFF_Q); bf16_t* Kb = (bf16_t*)(ws + OFF_K);
    bf16_t* MA = (bf16_t*)(ws + OFF_MA); bf16_t* MTC = (bf16_t*)(ws + OFF_MTC); bf16_t* CAR = (bf16_t*)(ws + OFF_CAR);
    bf16_t* Zb = (bf16_t*)(ws + OFF_Z); bf16_t* S5O = (bf16_t*)(ws + OFF_S5OUT); bf16_t* MRG = (bf16_t*)(ws + OFF_MERGED); bf16_t* ACT = (bf16_t*)(ws + OFF_ACT); bf16_t* H2 = (bf16_t*)(ws + OFF_H2);
    bf16_t* QM = (bf16_t*)((char*)p.out + DOFF_QM); bf16_t* VT = (bf16_t*)((char*)p.out + DOFF_VT); bf16_t* HR = VT;

    transpose_w<false>(p.w_in, 1024, 8192, WT_IN, smem);
    transpose_w<false>(p.w_glu, 1024, 1024, WT_GLU, smem);
    transpose_w<false>(p.w_mkv, 1024, 2048, WT_MKV, smem);
    for (int n3 = 0; n3 < 3; ++n3) transpose_w<false>(p.w_branch + (size_t)n3 * 1024 * 1024, 1024, 1024, WT_BR + (size_t)n3 * 1024 * 1024, smem);
    transpose_w<false>(p.w_out, 1024, 1024, WT_OUT, smem);
    transpose_w<true>(p.w_gu, 1024, 2 * DFF, WT_GU, smem);
    transpose_w<false>(p.w_dn, DFF, 1024, WT_DN, smem);
    for (int it = bid; it < TT / 4; it += nb) { PHASE_IDS const int t = it * 4 + w; const float* src = t < TP ? p.x_p + (size_t)t * DM : p.x_s + (size_t)(t - TP) * DM; rms_row(src, p.norm_mix_g, Hh + (size_t)t * DM, lane); }
    for (int it = bid; it < 8192 / 4; it += nb) { PHASE_IDS const int r = it * 4 + w; const float* src = r < 4096 ? p.mem_p + (size_t)r * DM : p.mem_s + (size_t)(r - 4096) * DM; rms_row(src, p.mem_norm_g, MEMN + (size_t)r * DM, lane); }
    for (int it = bid; it < 4096 * 32 / 256; it += nb) { PHASE_IDS const int i = it * 256 + tid, pos = i >> 5, d = i & 31;
        const float inv = powf(10000.f, -(float)d / 32.f); float sn, cs; sincosf((float)pos * inv, &sn, &cs); ROPE[pos * 64 + d] = cs; ROPE[pos * 64 + 32 + d] = sn; }
    if (PM & 4) for (int it = bid; it < 128; it += nb) s5_prep(p, it >> 1, it & 1, smem);
    GRID_SYNC();

    {
        const int n_in = (TT / BM) * 40, n_mkv = (8192 / BM) * 16, n_exp = 64 * 512 * 64 / 256;
        for (int it = bid; it < n_in + n_mkv + n_exp; it += nb) {
            PHASE_IDS
            if (it < n_in) {
                const int mt = it / 40, nt = it % 40, seg = nt >> 3, row0 = mt * BM, n0 = nt * 128;
                APlain af{Hh, DM};
                int s0, L; seq_info(row0, s0, L);
                if (seg == 3) {
                    f32x4 acc[MT][4]; zero_acc<4>(acc);
                    gemm_main<4, false>(acc, af, row0, WT_IN, DM, n0, DM, smem);
#pragma unroll
                    for (int m = 0; m < MT; ++m)
#pragma unroll
                        for (int n = 0; n < 4; ++n) { const int pos = row0 - s0 + wr * WM + m * 16 + 4 * lg, col = (nt & 7) * 128 + wc * 64 + n * 16 + lr;
                            st4bf(VT + (size_t)s0 * DM + (size_t)col * L + pos, acc[m][n][0], acc[m][n][1], acc[m][n][2], acc[m][n][3]); }
                } else {
                    f32x4 acc[MT][4]; zero_acc<4>(acc);
                    gemm_main<4, true>(acc, af, row0, WT_IN, DM, n0, DM, smem);
                    const int cb = (nt & 7) * 128 + wc * 64 + 4 * lg;
                    if (seg == 0) {
#pragma unroll
                        for (int m = 0; m < MT; ++m) { const int row = row0 + wr * WM + m * 16 + lr;
#pragma unroll
                            for (int n = 0; n < 4; ++n) { const int g = (nt & 7) * 8 + wc * 4 + n;
                                st4bf(Ub + ((size_t)g * NCH + (row >> 5)) * 512 + (row & 31) * 16 + 4 * lg, acc[m][n][0], acc[m][n][1], acc[m][n][2], acc[m][n][3]); } }
                    } else if (seg == 4) {
#pragma unroll
                        for (int m = 0; m < MT; ++m) { const int row = row0 + wr * WM + m * 16 + lr;
#pragma unroll
                            for (int n = 0; n < 4; ++n) st4bf(QM + (size_t)row * DM + cb + n * 16, acc[m][n][0], acc[m][n][1], acc[m][n][2], acc[m][n][3]); }
                    } else {
                        const float* gain = seg == 1 ? p.q_g : p.k_g; bf16_t* dst = seg == 1 ? Qb : Kb;
                        const float osc = seg == 1 ? 0.125f * 1.4426950408889634f : 1.f;
                        f32x4 gn[4];
#pragma unroll
                        for (int n = 0; n < 4; ++n) gn[n] = *(const f32x4*)(gain + n * 16 + 4 * lg);
#pragma unroll
                        for (int m = 0; m < MT; ++m) { const int row = row0 + wr * WM + m * 16 + lr, pos = row - s0;
                            float ss = 0.f;
#pragma unroll
                            for (int n = 0; n < 4; ++n)
#pragma unroll
                                for (int j = 0; j < 4; ++j) ss += acc[m][n][j] * acc[m][n][j];
                            ss += __shfl_xor(ss, 16); ss += __shfl_xor(ss, 32);
                            const float rstd = rsqrtf(ss * (1.f / 64.f) + EPS);
                            f32x4 o[4];
#pragma unroll
                            for (int n = 0; n < 2; ++n) { const f32x4 cs = *(const f32x4*)(ROPE + pos * 64 + n * 16 + 4 * lg), sn = *(const f32x4*)(ROPE + pos * 64 + 32 + n * 16 + 4 * lg);
#pragma unroll
                                for (int j = 0; j < 4; ++j) { const float x1 = acc[m][n][j] * rstd * gn[n][j], x2 = acc[m][n + 2][j] * rstd * gn[n + 2][j];
                                    o[n][j] = (x1 * cs[j] - x2 * sn[j]) * osc; o[n + 2][j] = (x1 * sn[j] + x2 * cs[j]) * osc; } }
#pragma unroll
                            for (int n = 0; n < 4; ++n) st4bf(dst + (size_t)row * DM + cb + n * 16, o[n][0], o[n][1], o[n][2], o[n][3]); }
                    }
                }
            } else if (it < n_in + n_mkv) {
                const int i2 = it - n_in, mt = i2 / 16, nt = i2 % 16, row0 = mt * BM, n0 = nt * 128;
                APlain af{MEMN, DM};
                if (nt < 8) {
                    f32x4 acc[MT][4]; zero_acc<4>(acc);
                    gemm_main<4, true>(acc, af, row0, WT_MKV, DM, n0, DM, smem);
                    const int cb = nt * 128 + wc * 64 + 4 * lg, head = nt >> 1;
#pragma unroll
                    for (int m = 0; m < MT; ++m) { const int row = row0 + wr * WM + m * 16 + lr; float ss = 0.f;
#pragma unroll
                        for (int n = 0; n < 4; ++n) { st4bf(MEMK + (size_t)row * DM + cb + n * 16, acc[m][n][0], acc[m][n][1], acc[m][n][2], acc[m][n][3]);
#pragma unroll
                            for (int j = 0; j < 4; ++j) ss += acc[m][n][j] * acc[m][n][j]; }
                        ss += __shfl_xor(ss, 16); ss += __shfl_xor(ss, 32);
                        if (lg == 0) SSQK[(head * 4 + (nt & 1) * 2 + wc) * 8192 + row] = ss; }
                } else {
                    f32x4 acc[MT][4]; zero_acc<4>(acc);
                    gemm_main<4, false>(acc, af, row0, WT_MKV, DM, n0, DM, smem);
#pragma unroll
                    for (int m = 0; m < MT; ++m)
#pragma unroll
                        for (int n = 0; n < 4; ++n) { const int row = row0 + wr * WM + m * 16 + 4 * lg, b = row >> 8, key = row & 255, col = (nt - 8) * 128 + wc * 64 + n * 16 + lr;
                            st4bf(MEMVT + ((size_t)b * 1024 + col) * 256 + key, acc[m][n][0], acc[m][n][1], acc[m][n][2], acc[m][n][3]); }
                }
            } else {
                const int i3 = (it - n_in - n_mkv) * 256 + tid;
                const int g = i3 >> 15, row = (i3 >> 6) & 511, kc = i3 & 63, ii = row >> 4, hp = row & 15, j = kc >> 1, h0 = (kc & 1) * 8;
                const float* Kc = (const float*)(ws + OFF_KC) + (size_t)g * 2 * 32 * 256;
                float v[8];
#pragma unroll
                for (int e = 0; e < 8; ++e) v[e] = 0.f;
                if (j <= ii) { const float* s = Kc + (ii - j) * 256 + hp * 16 + h0;
#pragma unroll
                    for (int e = 0; e < 8; ++e) v[e] += s[e]; }
                if (j >= ii) { const float* s = Kc + 32 * 256 + (j - ii) * 256 + hp * 16 + h0;
#pragma unroll
                    for (int e = 0; e < 8; ++e) v[e] += s[e]; }
                if (j == ii) {
#pragma unroll
                    for (int e = 0; e < 8; ++e) if (h0 + e == hp) v[e] += p.s5_d[g * 16 + hp]; }
                uint4 o; o.x = pk2(v[0], v[1]); o.y = pk2(v[2], v[3]); o.z = pk2(v[4], v[5]); o.w = pk2(v[6], v[7]);
                *(uint4*)(MTC + ((size_t)g * 512 + row) * 768 + j * 16 + h0) = o;
            }
        }
    }
    GRID_SYNC();

    for (int it = bid; it < 64 * (NCH / BM) * 2; it += nb) {
        PHASE_IDS
        int g = it / ((NCH / BM) * 2), r = it % ((NCH / BM) * 2);
        if ((nb & 7) == 0 && (64 * (NCH / BM) * 2) % nb == 0) {
            const int lu = (it / nb) * (nb >> 3) + (bid >> 3); g = (lu / ((NCH / BM) * 2)) * 8 + (bid & 7); r = lu % ((NCH / BM) * 2); }
        const int ct = r >> 1, nt = r & 1;
        AS5 af{Ub, CAR, g};
        f32x4 acc[MT][4]; zero_acc<4>(acc);
        gemm_main<4, true>(acc, af, ct * BM, MA + (size_t)g * 256 * 512, 512, nt * 128, 512, smem);
#pragma unroll
        for (int m = 0; m < MT; ++m) { const int chunk = ct * BM + wr * WM + m * 16 + lr;
#pragma unroll
            for (int n = 0; n < 4; ++n) st4bf(CAR + ((size_t)g * NCH + chunk) * 256 + nt * 128 + wc * 64 + n * 16 + 4 * lg, acc[m][n][0], acc[m][n][1], acc[m][n][2], acc[m][n][3]); }
    }
    GRID_SYNC();

    for (int it = bid; it < 32 * 64 * 128 / 256; it += nb) {
        PHASE_IDS
        const int i = it * 256 + tid, pd = i & 127, g = (i >> 7) & 63, b = i >> 13, dir = pd >> 6, pp = pd & 63;
        const int gd = dir * 64 + g;
        const float dt = expf(p.log_dt[gd]);
        const float lre = p.lam_re[gd * 64 + pp], lim = p.lam_im[gd * 64 + pp];
        const float mag = expf(32.f * lre * dt); float sn, cs; sincosf(32.f * lim * dt, &sn, &cs);
        const float ar = mag * cs, ai = mag * sn;
        const int c0 = b < 16 ? b * 64 : 1024 + (b - 16) * 128, nc = b < 16 ? 64 : 128;
        unsigned* base = (unsigned*)(CAR + ((size_t)g * NCH + c0) * 256 + pd * 2);
        float sr = 0.f, si = 0.f;
        for (int c8 = 0; c8 < nc; c8 += 8) {
            unsigned ev[8];
#pragma unroll
            for (int u = 0; u < 8; ++u) { const int cc = dir == 0 ? c8 + u : nc - 1 - (c8 + u); ev[u] = base[(size_t)cc * 128]; }
#pragma unroll
            for (int u = 0; u < 8; ++u) { const int cc = dir == 0 ? c8 + u : nc - 1 - (c8 + u);
                base[(size_t)cc * 128] = pk2(sr, si);
                const float er = bflo(ev[u]), ei = bfhi(ev[u]);
                const float nr = ar * sr - ai * si + er, ni = ar * si + ai * sr + ei;
                sr = nr; si = ni; }
        }
    }
    GRID_SYNC();

    {
        constexpr int DQ = 64 * DIFF_MQ, NQS = 4096 / DQ, NQP = 2048 / DQ;
        const int n_ds = 16 * 8 * NQS, n_dp = 16 * 8 * NQP, n_s5 = 64 * (NCH / BM) * 4, n_mem = (TT / (MEM_MQ * 64)) * 4;
        if (PM & 1) for (int it = bid; it < n_ds + n_dp; it += nb) {
            PHASE_IDS
            {
                int b, h, qt, L, s0;
                if ((nb & 7) == 0 && (n_ds + n_dp) % nb == 0) {
                    const int xcd = bid & 7, slot = bid >> 3, spx = nb >> 3, rnd = it / nb;
                    const int lu = rnd * spx + slot;
                    const int per_s = 16 * NQS;
                    if (lu < per_s) { L = 4096; const int bh = (lu / NQS) * 8 + xcd; qt = lu % NQS; b = bh >> 3; h = bh & 7; s0 = TP + b * 4096; }
                    else { const int l2 = lu - per_s; L = 2048; const int bh = (l2 / NQP) * 8 + xcd; qt = l2 % NQP; b = bh >> 3; h = bh & 7; s0 = b * 2048; }
                } else
                if (it < n_ds) { L = 4096; b = it / (8 * NQS); const int r = it % (8 * NQS); h = r / NQS; qt = r % NQS; s0 = TP + b * 4096; }
                else { const int i2 = it - n_ds; L = 2048; b = i2 / (8 * NQP); const int r = i2 % (8 * NQP); h = r / NQP; qt = r % NQP; s0 = b * 2048; }
                const int q0 = s0 + qt * DQ + w * (16 * DIFF_MQ);
                float bnd;
                { float gq = fabsf(p.q_g[lane]), gk = fabsf(p.k_g[lane]);
#pragma unroll
                  for (int o = 32; o > 0; o >>= 1) { gq = fmaxf(gq, __shfl_xor(gq, o)); gk = fmaxf(gk, __shfl_xor(gk, o)); }
                  bnd = fminf(64.f * gq * gk * (0.125f * 1.4426950408889634f), 60.f); }
                f32x4 O[DIFF_MQ][8];
                {
                    bf16x8 Qf[DIFF_MQ][2];
#pragma unroll
                    for (int mq = 0; mq < DIFF_MQ; ++mq)
#pragma unroll
                        for (int kk = 0; kk < 2; ++kk) Qf[mq][kk] = *(const bf16x8*)(Qb + (size_t)(q0 + mq * 16 + lr) * DM + (2 * h) * 64 + kk * 32 + lg * 8);
                    attn_pass<64, 128, DIFF_MQ, false, true>(O, Qf, Kb + (size_t)s0 * DM + (2 * h) * 64, DM, VT + (size_t)s0 * DM + (size_t)(h * 128) * L, L, L, nullptr, bnd, smem);
#pragma unroll
                    for (int mq = 0; mq < DIFF_MQ; ++mq)
#pragma unroll
                        for (int kk = 0; kk < 2; ++kk) Qf[mq][kk] = *(const bf16x8*)(Qb + (size_t)(q0 + mq * 16 + lr) * DM + (2 * h + 1) * 64 + kk * 32 + lg * 8);
                    asm volatile("s_waitcnt vmcnt(0)" ::: "memory");
#pragma unroll
                    for (int mq = 0; mq < DIFF_MQ; ++mq)
#pragma unroll
                        for (int n = 0; n < 8; ++n) { uint2 v; v.x = pk2(O[mq][n][0], O[mq][n][1]); v.y = pk2(O[mq][n][2], O[mq][n][3]);
#if ATT_PIPE == 2
                            *(uint2*)(Qb + (size_t)(q0 + mq * 16 + lr) * DM + h * 128 + n * 16 + 4 * lg) = v; }
#else
                            *(uint2*)(smem + 49152 + ((w * DIFF_MQ + mq) * 8 + n) * 512 + lane * 8) = v; }
#endif
                    __syncthreads();
                    attn_pass<64, 128, DIFF_MQ, false, true>(O, Qf, Kb + (size_t)s0 * DM + (2 * h + 1) * 64, DM, VT + (size_t)s0 * DM + (size_t)(h * 128) * L, L, L, nullptr, bnd, smem);
                }
                float d1 = p.lq1[lane] * p.lk1[lane], d2 = p.lq2[lane] * p.lk2[lane];
#pragma unroll
                for (int o = 32; o > 0; o >>= 1) { d1 += __shfl_xor(d1, o); d2 += __shfl_xor(d2, o); }
                const float lam = expf(d1) - expf(d2) + 0.2f;
#pragma unroll
                for (int mq = 0; mq < DIFF_MQ; ++mq) {
                    float ss = 0.f;
#pragma unroll
                    for (int n = 0; n < 8; ++n) {
#if ATT_PIPE == 2
                        uint2 o1; { const unsigned long long ov = __hip_atomic_load((const unsigned long long*)(Qb + (size_t)(q0 + mq * 16 + lr) * DM + h * 128 + n * 16 + 4 * lg), __ATOMIC_RELAXED, __HIP_MEMORY_SCOPE_AGENT); o1.x = (unsigned)ov; o1.y = (unsigned)(ov >> 32); }
#else
                        const uint2 o1 = *(const uint2*)(smem + 49152 + ((w * DIFF_MQ + mq) * 8 + n) * 512 + lane * 8);
#endif
                        O[mq][n][0] = bflo(o1.x) - lam * O[mq][n][0]; O[mq][n][1] = bfhi(o1.x) - lam * O[mq][n][1];
                        O[mq][n][2] = bflo(o1.y) - lam * O[mq][n][2]; O[mq][n][3] = bfhi(o1.y) - lam * O[mq][n][3];
#pragma unroll
                        for (int j = 0; j < 4; ++j) ss += O[mq][n][j] * O[mq][n][j];
                    }
                    ss += __shfl_xor(ss, 16); ss += __shfl_xor(ss, 32);
                    const float sc = rsqrtf(ss * (1.f / 128.f) + EPS) * 0.8f;
                    bf16_t* dst = Qb + (size_t)(q0 + mq * 16 + lr) * DM + h * 128 + 4 * lg;
#pragma unroll
                    for (int n = 0; n < 8; ++n) { const f32x4 sg = *(const f32x4*)(p.sub_g + n * 16 + 4 * lg);
                        st4bf(dst + n * 16, O[mq][n][0] * sc * sg[0], O[mq][n][1] * sc * sg[1], O[mq][n][2] * sc * sg[2], O[mq][n][3] * sc * sg[3]); }
                }
            }
        }
        for (int it = bid; it < n_s5; it += nb) {
            PHASE_IDS
            {
                int g = it / ((NCH / BM) * 4), r = it % ((NCH / BM) * 4);
                if ((nb & 7) == 0 && n_s5 % nb == 0) {
                    const int lu = (it / nb) * (nb >> 3) + (bid >> 3); g = (lu / ((NCH / BM) * 4)) * 8 + (bid & 7); r = lu % ((NCH / BM) * 4); }
                const int ct = r >> 2, nt = r & 3;
                AS5 af{Ub, CAR, g};
                f32x4 acc[MT][4]; zero_acc<4>(acc);
                gemm_main<4, true>(acc, af, ct * BM, MTC + (size_t)g * 512 * 768, 768, nt * 128, 768, smem);
#pragma unroll
                for (int m = 0; m < MT; ++m) { const int chunk = ct * BM + wr * WM + m * 16 + lr;
#pragma unroll
                    for (int n = 0; n < 4; ++n) { const int ii = nt * 8 + wc * 4 + n; const size_t tok = (size_t)chunk * 32 + ii;
                        st4bf(Zb + tok * DM + g * 16 + 4 * lg, gelu_tanh(acc[m][n][0]), gelu_tanh(acc[m][n][1]), gelu_tanh(acc[m][n][2]), gelu_tanh(acc[m][n][3])); } }
            }
        }
        if (PM & 2) for (int it = bid; it < n_mem; it += nb) {
            PHASE_IDS
            {
                const int i2 = it, tq = i2 >> 2, head = i2 & 3;
                const int t0 = tq * (MEM_MQ * 64); int s0, L; seq_info(t0, s0, L);
                const int b = t0 < TP ? t0 / 2048 : 16 + (t0 - TP) / 4096;
                float bnd;
                { float gg = 0.f;
#pragma unroll
                  for (int e = 0; e < 4; ++e) gg = fmaxf(gg, fabsf(p.mem_q_g[lane * 4 + e] * p.mem_k_g[lane * 4 + e]));
#pragma unroll
                  for (int o = 32; o > 0; o >>= 1) gg = fmaxf(gg, __shfl_xor(gg, o));
                  bnd = fminf(256.f * gg * (0.0625f * 1.4426950408889634f), 60.f); }
                bf16x8 Qf[MEM_MQ][8];
#pragma unroll
                for (int mq = 0; mq < MEM_MQ; ++mq) {
                    const int qrow = t0 + w * (MEM_MQ * 16) + mq * 16 + lr;
                    uint4 raw[8]; float ss = 0.f;
#pragma unroll
                    for (int kk = 0; kk < 8; ++kk) { raw[kk] = *(const uint4*)(QM + (size_t)qrow * DM + head * 256 + kk * 32 + lg * 8);
                        const unsigned ww[4] = {raw[kk].x, raw[kk].y, raw[kk].z, raw[kk].w};
#pragma unroll
                        for (int e = 0; e < 4; ++e) { const float a = bflo(ww[e]), c = bfhi(ww[e]); ss += a * a + c * c; } }
                    ss += __shfl_xor(ss, 16); ss += __shfl_xor(ss, 32);
                    const float sc = rsqrtf(ss * (1.f / 256.f) + EPS) * (0.0625f * 1.4426950408889634f);
#pragma unroll
                    for (int kk = 0; kk < 8; ++kk) { const int d0 = kk * 32 + lg * 8;
                        const unsigned ww[4] = {raw[kk].x, raw[kk].y, raw[kk].z, raw[kk].w}; unsigned oo[4];
#pragma unroll
                        for (int e = 0; e < 4; ++e) { const int d = d0 + 2 * e;
                            oo[e] = pk2(bflo(ww[e]) * sc * p.mem_q_g[d] * p.mem_k_g[d], bfhi(ww[e]) * sc * p.mem_q_g[d + 1] * p.mem_k_g[d + 1]); }
                        uint4 pw; pw.x = oo[0]; pw.y = oo[1]; pw.z = oo[2]; pw.w = oo[3]; Qf[mq][kk] = *(bf16x8*)&pw; }
                }
                f32x4 O[MEM_MQ][16];
                attn_pass<256, 256, MEM_MQ, true, false>(O, Qf, MEMK + (size_t)(b * 256) * DM + head * 256, DM, MEMVT + ((size_t)b * 1024 + head * 256) * 256, 256, 256,
                                                    SSQK + head * 4 * 8192 + b * 256, bnd, smem);
#pragma unroll
                for (int mq = 0; mq < MEM_MQ; ++mq) {
                    bf16_t* dst = QM + (size_t)(t0 + w * (MEM_MQ * 16) + mq * 16 + lr) * DM + head * 256 + 4 * lg;
#pragma unroll
                    for (int n = 0; n < 16; ++n) st4bf(dst + n * 16, O[mq][n][0], O[mq][n][1], O[mq][n][2], O[mq][n][3]);
                }
            }
        }
    }
    GRID_SYNC();

    {
        const int n_glu = (TT / BM) * 8;
        for (int it = bid; it < n_glu + TT / 4; it += nb) {
            PHASE_IDS
            if (it < n_glu) {
                const int mt = (it >> 6) * 8 + (it & 7), nt = (it >> 3) & 7, row0 = mt * BM, n0 = nt * 128;
                APlain af{Zb, DM};
                f32x4 acc[MT][4]; zero_acc<4>(acc);
                gemm_main<4, true>(acc, af, row0, WT_GLU, DM, n0, DM, smem);
#pragma unroll
                for (int m = 0; m < MT; ++m) { const int row = row0 + wr * WM + m * 16 + lr;
#pragma unroll
                    for (int n = 0; n < 4; ++n) { const size_t o = (size_t)row * DM + n0 + wc * 64 + n * 16 + 4 * lg; const uint2 zz = *(const uint2*)(Zb + o);
                        st4bf(S5O + o, bflo(zz.x) * sigmoidf_(acc[m][n][0]), bfhi(zz.x) * sigmoidf_(acc[m][n][1]), bflo(zz.y) * sigmoidf_(acc[m][n][2]), bfhi(zz.y) * sigmoidf_(acc[m][n][3])); } }
            } else {
                const int t = (it - n_glu) * 4 + w; const float* src = t < TP ? p.x_p + (size_t)t * DM : p.x_s + (size_t)(t - TP) * DM; rms_row(src, p.norm_mix_g, HR + (size_t)t * DM, lane);
            }
        }
    }
    GRID_SYNC();

    if (PM & 8) for (int it = bid; it < (TT / BM) * 8; it += nb) {
        PHASE_IDS
        const int mt = (it >> 6) * 8 + (it & 7), nt = (it >> 3) & 7, row0 = mt * BM, n0 = nt * 128;
#pragma unroll 1
        for (int n3 = 0; n3 < 3; ++n3) {
            unsigned gpk[MT][4][2];
            {
                f32x4 ga[MT][4]; zero_acc<4>(ga);
                APlain af{HR, DM}; gemm_main_pf<4, true, 2>(ga, af, row0, WT_IN + (size_t)(5120 + n3 * 1024) * DM, DM, n0, DM, smem);
#pragma unroll
                for (int n = 0; n < 4; ++n) { const f32x4 bg = *(const f32x4*)(p.b_gate + n3 * 1024 + n0 + wc * 64 + n * 16 + 4 * lg);
#pragma unroll
                    for (int m = 0; m < MT; ++m) { gpk[m][n][0] = pk2(sigmoidf_(ga[m][n][0] + bg[0]), sigmoidf_(ga[m][n][1] + bg[1]));
                                                   gpk[m][n][1] = pk2(sigmoidf_(ga[m][n][2] + bg[2]), sigmoidf_(ga[m][n][3] + bg[3])); } }
            }
            f32x4 ba[MT][4]; zero_acc<4>(ba);
            { APlain af{n3 == 0 ? S5O : (n3 == 1 ? Qb : QM), DM}; gemm_main_pf<4, true, 2>(ba, af, row0, WT_BR + (size_t)n3 * 1024 * 1024, DM, n0, DM, smem); }
#pragma unroll
            for (int m = 0; m < MT; ++m) { const int row = row0 + wr * WM + m * 16 + lr;
#pragma unroll
                for (int n = 0; n < 4; ++n) {
                    unsigned long long* dst = (unsigned long long*)(MRG + (size_t)row * DM + n0 + wc * 64 + n * 16 + 4 * lg);
                    unsigned lo = 0u, hi = 0u;
                    if (n3 > 0) { const unsigned long long old = __hip_atomic_load(dst, __ATOMIC_RELAXED, __HIP_MEMORY_SCOPE_AGENT); lo = (unsigned)old; hi = (unsigned)(old >> 32); }
                    lo = pk2(fmaf(bflo(gpk[m][n][0]), ba[m][n][0], bflo(lo)), fmaf(bfhi(gpk[m][n][0]), ba[m][n][1], bfhi(lo)));
                    hi = pk2(fmaf(bflo(gpk[m][n][1]), ba[m][n][2], bflo(hi)), fmaf(bfhi(gpk[m][n][1]), ba[m][n][3], bfhi(hi)));
                    *dst = ((unsigned long long)hi << 32) | lo; } }
        }
    }
    GRID_SYNC();

    for (int it = bid; it < (TT / BM) * 8; it += nb) {
        PHASE_IDS
        const int mt = (it >> 6) * 8 + (it & 7), nt = (it >> 3) & 7, row0 = mt * BM, n0 = nt * 128;
        APlain af{MRG, DM};
        f32x4 acc[MT][4]; zero_acc<4>(acc);
        gemm_main<4, true>(acc, af, row0, WT_OUT, DM, n0, DM, smem);
#pragma unroll
        for (int m = 0; m < MT; ++m) { const int row = row0 + wr * WM + m * 16 + lr;
            const float* xr = row < TP ? p.x_p + (size_t)row * DM : p.x_s + (size_t)(row - TP) * DM;
#pragma unroll
            for (int n = 0; n < 4; ++n) { const int col = n0 + wc * 64 + n * 16 + 4 * lg; const f32x4 xv = *(const f32x4*)(xr + col);
                *(f32x4*)(p.out + (size_t)row * DM + col) = xv + acc[m][n]; } }
    }
    GRID_SYNC();

    for (int it = bid; it < TT / 4; it += nb) { PHASE_IDS const int t = it * 4 + w; rms_row(p.out + (size_t)t * DM, p.ffn_norm_g, H2 + (size_t)t * DM, lane); }
    GRID_SYNC();

#ifdef REP9
    for (int rep = 0; rep < REP9; ++rep)
#endif
    for (int it = bid; it < (TT / BM) * 44; it += nb) {
        PHASE_IDS
        const int mt = it / 44, jt = it % 44, row0 = mt * BM, n0 = jt * 128;
        APlain af{H2, DM};
        f32x4 acc[MT][4]; zero_acc<4>(acc);
        gemm_main<4, true>(acc, af, row0, WT_GU, DM, n0, DM, smem);
#pragma unroll
        for (int m = 0; m < MT; ++m) { const int row = row0 + wr * WM + m * 16 + lr;
#pragma unroll
            for (int pi = 0; pi < 2; ++pi) { const f32x4 gg = acc[m][2 * pi], uu = acc[m][2 * pi + 1];
                st4bf(ACT + (size_t)row * DFF + jt * 64 + wc * 32 + pi * 16 + 4 * lg, gg[0] * sigmoidf_(gg[0]) * uu[0], gg[1] * sigmoidf_(gg[1]) * uu[1], gg[2] * sigmoidf_(gg[2]) * uu[2], gg[3] * sigmoidf_(gg[3]) * uu[3]); } }
    }
    GRID_SYNC();

    for (int it = bid; it < (TT / BM) * 8; it += nb) {
        PHASE_IDS
        const int mt = (it >> 6) * 8 + (it & 7), nt = (it >> 3) & 7, row0 = mt * BM, n0 = nt * 128;
        APlain af{ACT, DFF};
        f32x4 acc[MT][4]; zero_acc<4>(acc);
        gemm_main_pf<4, true, 2>(acc, af, row0, WT_DN, DFF, n0, DFF, smem);
#pragma unroll
        for (int m = 0; m < MT; ++m) { const int row = row0 + wr * WM + m * 16 + lr;
#pragma unroll
            for (int n = 0; n < 4; ++n) { float* o = p.out + (size_t)row * DM + n0 + wc * 64 + n * 16 + 4 * lg; const f32x4 xv = *(const f32x4*)o; *(f32x4*)o = xv + acc[m][n]; } }
    }
}

extern "C" void kernel_launch(void* const* d_in, const int* in_sizes, int n_in, void* d_out, int out_size, void* d_ws, size_t ws_size, hipStream_t stream) {
    static int grid_blocks = 0;
    if (!grid_blocks) {
        int dev = 0, cus = 0, per_cu = 0;
        hipGetDevice(&dev);
        hipDeviceGetAttribute(&cus, hipDeviceAttributeMultiprocessorCount, dev);
        hipFuncSetAttribute((const void*)fwd_megakernel, hipFuncAttributeMaxDynamicSharedMemorySize, LDS_BYTES);
        hipOccupancyMaxActiveBlocksPerMultiprocessor(&per_cu, fwd_megakernel, 256, LDS_BYTES);
        if (per_cu > 2) per_cu = 2;
        if (per_cu < 1) per_cu = 1;
        grid_blocks = cus * per_cu;
    }
    if (ws_size < OFF_END) { fprintf(stderr, "workspace too small: %zu\n", ws_size); return; }
    Params p{};
    const float* const* in = (const float* const*)d_in;
    p.x_p = in[0]; p.x_s = in[1]; p.mem_p = in[2]; p.mem_s = in[3]; p.norm_mix_g = in[4]; p.w_in = in[5]; p.b_gate = in[6];
    p.lam_re = in[7]; p.lam_im = in[8]; p.log_dt = in[9]; p.b_re = in[10]; p.b_im = in[11]; p.c_re = in[12]; p.c_im = in[13];
    p.s5_d = in[14]; p.w_glu = in[15]; p.q_g = in[16]; p.k_g = in[17]; p.lq1 = in[18]; p.lk1 = in[19]; p.lq2 = in[20]; p.lk2 = in[21]; p.sub_g = in[22];
    p.mem_norm_g = in[23]; p.w_mkv = in[24]; p.mem_q_g = in[25]; p.mem_k_g = in[26]; p.w_branch = in[27]; p.w_out = in[28]; p.ffn_norm_g = in[29];
    p.w_gu = in[30]; p.w_dn = in[31];
    p.out = (float*)d_out; p.ws = (char*)d_ws;
    void* args[] = {&p};
    hipError_t e = hipLaunchCooperativeKernel((void*)fwd_megakernel, dim3(grid_blocks), dim3(256), args, LDS_BYTES, stream);
    if (e != hipSuccess) fprintf(stderr, "cooperative launch failed: %s (grid %d)\n", hipGetErrorString(e), grid_blocks);
}
```

```cpp
#include <hip/hip_runtime.h>
#include <hip/hip_cooperative_groups.h>
#include <cstdio>
#include <cstdint>
namespace cg = cooperative_groups;
#ifndef ATT_PIPE
#define ATT_PIPE 2
#endif
#ifndef GEMM_PF
#define GEMM_PF 3
#endif

typedef unsigned short bf16_t;
typedef short bf16x8 __attribute__((ext_vector_type(8)));
typedef float f32x4 __attribute__((ext_vector_type(4)));
typedef unsigned u32x4 __attribute__((ext_vector_type(4)));

constexpr int DM = 1024;
constexpr int TP = 16 * 2048, TS = 16 * 4096, TT = TP + TS;
constexpr int NCH = TT / 32;
constexpr int DFF = 2816;
constexpr float EPS = 1e-6f;
constexpr size_t MiB = 1024ull * 1024ull;
constexpr int MT = 4, BM = 32 * MT, WM = 16 * MT;
constexpr int LDS_BYTES = 81920;

constexpr size_t OFF_WT_IN = 0, OFF_WT_GLU = 16 * MiB, OFF_WT_MKV = 18 * MiB, OFF_WT_BR = 22 * MiB, OFF_WT_OUT = 28 * MiB,
                 OFF_WT_GU = 30 * MiB, OFF_WT_DN = 41 * MiB, OFF_ROPE = 46 * MiB + 512 * 1024, OFF_SSQK = 47 * MiB + 512 * 1024,
                 OFF_MEMN = 48 * MiB, OFF_MEMK = 64 * MiB, OFF_MEMVT = 80 * MiB, OFF_H = 96 * MiB, OFF_U = 288 * MiB, OFF_Q = 480 * MiB,
                 OFF_K = 672 * MiB, OFF_MA = 864 * MiB, OFF_MTC = 880 * MiB, OFF_CAR = 928 * MiB, OFF_END = 1024 * MiB;
constexpr size_t OFF_KC = OFF_CAR;
constexpr size_t OFF_Z = OFF_H;
constexpr size_t OFF_S5OUT = OFF_U;
constexpr size_t OFF_MERGED = OFF_K;
constexpr size_t OFF_ACT = OFF_H;
constexpr size_t OFF_H2 = OFF_K;
constexpr size_t DOFF_QM = 0, DOFF_VT = 192 * MiB;

struct Params {
    const float* x_p; const float* x_s; const float* mem_p; const float* mem_s;
    const float* norm_mix_g; const float* w_in; const float* b_gate;
    const float* lam_re; const float* lam_im; const float* log_dt; const float* b_re; const float* b_im; const float* c_re; const float* c_im;
    const float* s5_d; const float* w_glu;
    const float* q_g; const float* k_g; const float* lq1; const float* lk1; const float* lq2; const float* lk2; const float* sub_g;
    const float* mem_norm_g; const float* w_mkv; const float* mem_q_g; const float* mem_k_g;
    const float* w_branch; const float* w_out; const float* ffn_norm_g; const float* w_gu; const float* w_dn;
    float* out; char* ws;
};

typedef __bf16 bf16v2_t __attribute__((ext_vector_type(2)));
typedef float f32v2_t __attribute__((ext_vector_type(2)));
__device__ __forceinline__ unsigned pk2(float lo, float hi) { f32v2_t v = {lo, hi}; bf16v2_t b = __builtin_convertvector(v, bf16v2_t); return __builtin_bit_cast(unsigned, b); }
__device__ __forceinline__ float bf2f(unsigned short v) { return __uint_as_float(((unsigned)v) << 16); }
__device__ __forceinline__ float bflo(unsigned v) { return __uint_as_float(v << 16); }
__device__ __forceinline__ float bfhi(unsigned v) { return __uint_as_float(v & 0xffff0000u); }
__device__ __forceinline__ void st4bf(bf16_t* p, float a, float b, float c, float d) { uint2 v; v.x = pk2(a, b); v.y = pk2(c, d); *(uint2*)p = v; }
__device__ __forceinline__ float sigmoidf_(float x) { return __builtin_amdgcn_rcpf(1.f + __expf(-x)); }
__device__ __forceinline__ float gelu_tanh(float y) { float a = 0.7978845608028654f * (y + 0.044715f * y * y * y); float e = __expf(2.f * a); float t = 1.f - 2.f * __builtin_amdgcn_rcpf(e + 1.f); return 0.5f * y * (1.f + t); }
__device__ __forceinline__ void seq_info(int t, int& s0, int& L) { if (t < TP) { L = 2048; s0 = t & ~2047; } else { L = 4096; s0 = TP + ((t - TP) & ~4095); } }
__device__ __forceinline__ int opaque_tid() { int t = threadIdx.x; asm volatile("" : "+v"(t)); return t; }
#define PHASE_IDS const int tid = opaque_tid(), lane = tid & 63, w = tid >> 6, wr = w >> 1, wc = w & 1, lr = lane & 15, lg = lane >> 4; (void)wr; (void)wc; (void)lr; (void)lg; (void)w; (void)lane;
#define MFMA16(a, b, c) __builtin_amdgcn_mfma_f32_16x16x32_bf16((a), (b), (c), 0, 0, 0)

struct APlain { const bf16_t* A; int lda; __device__ __forceinline__ const bf16_t* operator()(int row, int k) const { return A + (size_t)row * lda + k; } };
struct AS5 { const bf16_t* U; const bf16_t* CAR; int g;
    __device__ __forceinline__ const bf16_t* operator()(int chunk, int k) const {
        return k < 512 ? U + ((size_t)g * NCH + chunk) * 512 + k : CAR + ((size_t)g * NCH + chunk) * 256 + (k - 512); } };

template <int NT, bool SWAP, int PF, class AF>
__device__ __forceinline__ void gemm_main_pf(f32x4 (&acc)[MT][NT], const AF& af, int row0, const bf16_t* __restrict__ Bt, int ldb, int n0, int K, char* lds) {
    const int tid = opaque_tid(), lane = tid & 63, w = tid >> 6, wr = w >> 1, wc = w & 1, lr = lane & 15, lg = lane >> 4;
    constexpr int NB = NT;
    constexpr int AB = BM * 128, STG = (BM + NT * 32) * 128;
    const int ldr = tid >> 3, ldc = tid & 7;
    const int swz = ((ldc ^ (ldr & 7)) << 4);
    u32x4 ra0[MT], rb0[NB], ra1[MT], rb1[NB];
    const int nk = K >> 6;
#define GM_GLOAD(RA, RB, KT) { const int k_ = (KT) * 64 + ldc * 8; _Pragma("unroll") for (int i = 0; i < MT; ++i) RA[i] = *(const u32x4*)af(row0 + ldr + 32 * i, k_); \
                       _Pragma("unroll") for (int i = 0; i < NB; ++i) RB[i] = *(const u32x4*)(Bt + (size_t)(n0 + ldr + 32 * i) * ldb + k_); }
#define GM_LSTORE(RA, RB, ST_) { char* base_ = lds + (ST_) * STG; _Pragma("unroll") for (int i = 0; i < MT; ++i) *(u32x4*)(base_ + (ldr + 32 * i) * 128 + swz) = RA[i]; \
                       _Pragma("unroll") for (int i = 0; i < NB; ++i) *(u32x4*)(base_ + AB + (ldr + 32 * i) * 128 + swz) = RB[i]; }
#define GM_COMPUTE(ST_) { const char* base = lds + (ST_) * STG; \
        _Pragma("unroll") for (int kk = 0; kk < 2; ++kk) { \
            bf16x8 fa[MT], fb[NT]; \
            const int co = (((kk * 4 + lg) ^ (lr & 7)) << 4); \
            _Pragma("unroll") for (int m = 0; m < MT; ++m) fa[m] = *(const bf16x8*)(base + (wr * WM + m * 16 + lr) * 128 + co); \
            _Pragma("unroll") for (int n = 0; n < NT; ++n) fb[n] = *(const bf16x8*)(base + AB + (wc * (NT * 16) + n * 16 + lr) * 128 + co); \
            _Pragma("unroll") for (int m = 0; m < MT; ++m) _Pragma("unroll") for (int n = 0; n < NT; ++n) acc[m][n] = SWAP ? MFMA16(fb[n], fa[m], acc[m][n]) : MFMA16(fa[m], fb[n], acc[m][n]); } }
    if constexpr (PF == 2) {
    GM_GLOAD(ra0, rb0, 0); GM_LSTORE(ra0, rb0, 0); GM_GLOAD(ra1, rb1, 1); __syncthreads();
    for (int kt = 0; kt < nk; kt += 2) {
        { const int k2 = kt + 2 < nk ? kt + 2 : nk - 1; GM_GLOAD(ra0, rb0, k2); }
        GM_COMPUTE(0);
        GM_LSTORE(ra1, rb1, 1);
        __syncthreads();
        { const int k3 = kt + 3 < nk ? kt + 3 : nk - 1; GM_GLOAD(ra1, rb1, k3); }
        GM_COMPUTE(1);
        if (kt + 2 < nk) GM_LSTORE(ra0, rb0, 0);
        __syncthreads();
    }
    } else if constexpr (PF == 3) {
    u32x4 ra2[MT], rb2[NB];
    GM_GLOAD(ra0, rb0, 0); GM_LSTORE(ra0, rb0, 0); GM_GLOAD(ra1, rb1, 1); { const int k2 = 2 < nk ? 2 : nk - 1; GM_GLOAD(ra2, rb2, k2); } __syncthreads();
#define GM_STEP(KT, RL_A, RL_B, RS_A, RS_B) { const int kt_ = (KT); \
        { const int k3 = kt_ + 3 < nk ? kt_ + 3 : nk - 1; GM_GLOAD(RL_A, RL_B, k3); } \
        GM_COMPUTE(kt_ & 1); \
        if (kt_ + 1 < nk) GM_LSTORE(RS_A, RS_B, (kt_ + 1) & 1); \
        __syncthreads(); }
    for (int kt = 0; kt < nk; kt += 3) {
        GM_STEP(kt, ra0, rb0, ra1, rb1);
        if (kt + 1 >= nk) break;
        GM_STEP(kt + 1, ra1, rb1, ra2, rb2);
        if (kt + 2 >= nk) break;
        GM_STEP(kt + 2, ra2, rb2, ra0, rb0);
    }
    } else {
    GM_GLOAD(ra0, rb0, 0); GM_LSTORE(ra0, rb0, 0); __syncthreads();
    for (int kt = 0; kt < nk; kt += 2) {
        GM_GLOAD(ra0, rb0, kt + 1);
        GM_COMPUTE(0);
        GM_LSTORE(ra0, rb0, 1);
        __syncthreads();
        { const int k2 = kt + 2 < nk ? kt + 2 : nk - 1; GM_GLOAD(ra0, rb0, k2); }
        GM_COMPUTE(1);
        if (kt + 2 < nk) GM_LSTORE(ra0, rb0, 0);
        __syncthreads();
    }
    }
}
template <int NT, bool SWAP, class AF>
__device__ __forceinline__ void gemm_main(f32x4 (&acc)[MT][NT], const AF& af, int row0, const bf16_t* __restrict__ Bt, int ldb, int n0, int K, char* lds) {
    __builtin_amdgcn_s_setprio(1);
    gemm_main_pf<NT, SWAP, (NT == 4 ? GEMM_PF : 2)>(acc, af, row0, Bt, ldb, n0, K, lds);
    __builtin_amdgcn_s_setprio(0);
}
template <int NT> __device__ __forceinline__ void zero_acc(f32x4 (&acc)[MT][NT]) {
#pragma unroll
    for (int m = 0; m < MT; ++m)
#pragma unroll
        for (int n = 0; n < NT; ++n) acc[m][n] = (f32x4){0.f, 0.f, 0.f, 0.f};
}

__device__ __forceinline__ void wait_vm6() { asm volatile("s_waitcnt vmcnt(6)" ::: "memory"); }
__device__ __forceinline__ void wait_vm0() { asm volatile("s_waitcnt vmcnt(0)" ::: "memory"); }
template <int DH> __device__ __forceinline__ int kswz(int row, int c) { return DH == 64 ? row * 128 + ((c ^ (row & 7)) << 4) : row * 512 + ((c ^ (row & 15)) << 4); }
template <int DH, int E, int MQ, bool KSC, bool DB>
__device__ __forceinline__ void attn_pass(f32x4 (&O)[MQ][E / 16], const bf16x8 (&Qf)[MQ][DH / 32], const bf16_t* __restrict__ Kp, int ldk,
                                          const bf16_t* __restrict__ Vt, int ldv, int nkeys, const float* __restrict__ ksq, float bnd, char* lds) {
    constexpr int KB = 64 * DH * 2, VB = E * 128, ST = KB + VB, KC = DH / 8, NKL = 64 * KC / 256, NVL = E * 8 / 256;
    const int tid = opaque_tid(), lane = tid & 63, lr = lane & 15, lg = lane >> 4;
    float lsum[MQ];
#pragma unroll
    for (int q = 0; q < MQ; ++q) { lsum[q] = 0.f;
#pragma unroll
        for (int n = 0; n < E / 16; ++n) O[q][n] = (f32x4){0.f, 0.f, 0.f, 0.f}; }
    u32x4 rk[NKL], rv[NVL];
#define GLOADK(T) { const int key0_ = (T) * 64; _Pragma("unroll") for (int i = 0; i < NKL; ++i) { const int q = tid + 256 * i, r = q / KC, c = q % KC; rk[i] = *(const u32x4*)(Kp + (size_t)(key0_ + r) * ldk + c * 8); } }
#define GLOADV(T) { const int key0_ = (T) * 64; _Pragma("unroll") for (int i = 0; i < NVL; ++i) { const int q = tid + 256 * i, e = q >> 3, c = q & 7; rv[i] = *(const u32x4*)(Vt + (size_t)e * ldv + key0_ + c * 8); } }
#define LSTOREK(STG) { char* base_ = lds + (STG) * ST; _Pragma("unroll") for (int i = 0; i < NKL; ++i) { const int q = tid + 256 * i, r = q / KC, c = q % KC; *(u32x4*)(base_ + kswz<DH>(r, c)) = rk[i]; } }
#define LSTOREV(STG) { char* base_ = lds + (STG) * ST; _Pragma("unroll") for (int i = 0; i < NVL; ++i) { const int q = tid + 256 * i, e = q >> 3, c = q & 7; *(u32x4*)(base_ + KB + e * 128 + ((c ^ ((e >> 1) & 7)) << 4)) = rv[i]; } }
#define ATT_QK(S_, BASE_, SINIT_) { \
        _Pragma("unroll") for (int q = 0; q < MQ; ++q) _Pragma("unroll") for (int k4 = 0; k4 < 4; ++k4) S_[q][k4] = (f32x4){SINIT_, SINIT_, SINIT_, SINIT_}; \
        _Pragma("unroll") for (int k4 = 0; k4 < 4; ++k4) _Pragma("unroll") for (int kk = 0; kk < DH / 32; ++kk) { \
            const bf16x8 kf = *(const bf16x8*)((BASE_) + kswz<DH>(k4 * 16 + lr, kk * 4 + lg)); \
            __builtin_amdgcn_s_setprio(1); _Pragma("unroll") for (int q = 0; q < MQ; ++q) S_[q][k4] = MFMA16(kf, Qf[q][kk], S_[q][k4]); __builtin_amdgcn_s_setprio(0); } }
#define ATT_SOFTMAX(S_) { \
        _Pragma("unroll") for (int q = 0; q < MQ; ++q) { float ps = 0.f; \
            _Pragma("unroll") for (int k4 = 0; k4 < 4; ++k4) _Pragma("unroll") for (int j = 0; j < 4; ++j) { const float pv = __builtin_amdgcn_exp2f(S_[q][k4][j]); S_[q][k4][j] = pv; ps += pv; } \
            lsum[q] += ps; \
            _Pragma("unroll") for (int k2 = 0; k2 < 2; ++k2) { uint4 pw; pw.x = pk2(S_[q][2 * k2][0], S_[q][2 * k2][1]); pw.y = pk2(S_[q][2 * k2][2], S_[q][2 * k2][3]); \
                pw.z = pk2(S_[q][2 * k2 + 1][0], S_[q][2 * k2 + 1][1]); pw.w = pk2(S_[q][2 * k2 + 1][2], S_[q][2 * k2 + 1][3]); Pf[q][k2] = *(bf16x8*)&pw; } } }
#define ATT_PV(BASE_) { \
        _Pragma("unroll") for (int k2 = 0; k2 < 2; ++k2) _Pragma("unroll") for (int n = 0; n < E / 16; ++n) { \
            const char* rowp = (BASE_) + KB + n * 2048; \
            uint4 vw; const uint2 v0 = *(const uint2*)(rowp + (k2 == 0 ? vo00 : vo10)), v1 = *(const uint2*)(rowp + (k2 == 0 ? vo01 : vo11)); \
            vw.x = v0.x; vw.y = v0.y; vw.z = v1.x; vw.w = v1.y; const bf16x8 vf = *(bf16x8*)&vw; \
            __builtin_amdgcn_s_setprio(1); _Pragma("unroll") for (int q = 0; q < MQ; ++q) O[q][n] = MFMA16(vf, Pf[q][k2], O[q][n]); __builtin_amdgcn_s_setprio(0); } }
    const int vsw = (lr >> 1) & 7;
    const int vo00 = lr * 128 + (lg & 1) * 8 + ((((lg >> 1)) ^ vsw) << 4), vo01 = lr * 128 + (lg & 1) * 8 + ((((lg >> 1) + 2) ^ vsw) << 4);
    const int vo10 = lr * 128 + (lg & 1) * 8 + (((4 + (lg >> 1)) ^ vsw) << 4), vo11 = lr * 128 + (lg & 1) * 8 + (((6 + (lg >> 1)) ^ vsw) << 4);
    const int nt = nkeys >> 6;
    bf16x8 Pf[MQ][2];
#if ATT_PIPE == 2
    if (DB) {
        const float sinit = -bnd;
        f32x4 Sc[MQ][4];
#define ATT_ISSUE(T, STG) { const int key0_ = (T) * 64; char* sb_ = lds + (STG) * ST + tid * 16; \
        _Pragma("unroll") for (int i = 0; i < NKL; ++i) { const int L_ = tid + 256 * i, r = L_ / KC, c = (L_ % KC) ^ (r & 7); \
            __builtin_amdgcn_global_load_lds((const unsigned*)(Kp + (size_t)(key0_ + r) * ldk + c * 8), (__attribute__((address_space(3))) unsigned*)(sb_ + i * 4096), 16, 0, 0); } \
        _Pragma("unroll") for (int i = 0; i < NVL; ++i) { const int L_ = tid + 256 * i, e = L_ >> 3, c = (L_ & 7) ^ ((e >> 1) & 7); \
            __builtin_amdgcn_global_load_lds((const unsigned*)(Vt + (size_t)e * ldv + key0_ + c * 8), (__attribute__((address_space(3))) unsigned*)(sb_ + KB + i * 4096), 16, 0, 0); } }
        static_assert(!DB || (DH == 64 && NKL + NVL == 6), "glds attention path is written for DH = 64, E = 128");
        ATT_ISSUE(0, 0); ATT_ISSUE(1, 1);
        wait_vm6(); __builtin_amdgcn_s_barrier(); asm volatile("" ::: "memory");
        int st = 0;
        for (int t = 0; t < nt; ++t) {
            const int st2 = st == 0 ? 2 : st - 1;
            if (t + 2 < nt) ATT_ISSUE(t + 2, st2);
            ATT_QK(Sc, lds + st * ST, sinit);
            ATT_SOFTMAX(Sc);
            ATT_PV(lds + st * ST);
            if (t + 2 < nt) wait_vm6(); else wait_vm0();
            __builtin_amdgcn_s_barrier(); asm volatile("" ::: "memory");
            st = st == 2 ? 0 : st + 1;
        }
    } else
#elif !ATT_PIPE
    if (DB) {
        const float sinit = -bnd;
        f32x4 Sc[MQ][4];
        GLOADK(0); GLOADV(0); LSTOREK(0); LSTOREV(0); __syncthreads();
        for (int t = 0; t < nt; ++t) {
            { const int t1_ = t + 1 < nt ? t + 1 : nt - 1; GLOADK(t1_); GLOADV(t1_); }
            ATT_QK(Sc, lds + (t & 1) * ST, sinit);
            ATT_SOFTMAX(Sc);
            ATT_PV(lds + (t & 1) * ST);
            if (t + 1 < nt) { LSTOREK((t + 1) & 1); LSTOREV((t + 1) & 1); }
            __syncthreads();
        }
    } else
#endif
    if (DB) {
        const float sinit = -bnd;
        f32x4 Sc[MQ][4], Sn[MQ][4];
        GLOADK(0); GLOADV(0); LSTOREK(0); LSTOREV(0); __syncthreads();
        { const int t1_ = nt > 1 ? 1 : 0; GLOADK(t1_); GLOADV(t1_); }
        ATT_QK(Sc, lds, sinit);
        for (int t = 0; t < nt; ++t) {
            __syncthreads();
            if (t + 1 < nt) { LSTOREK((t + 1) & 1); LSTOREV((t + 1) & 1); }
            __syncthreads();
            { const int t2_ = t + 2 < nt ? t + 2 : nt - 1; GLOADK(t2_); GLOADV(t2_); }
            if (t + 1 < nt) ATT_QK(Sn, lds + ((t + 1) & 1) * ST, sinit);
            ATT_SOFTMAX(Sc);
            ATT_PV(lds + (t & 1) * ST);
#pragma unroll
            for (int q = 0; q < MQ; ++q)
#pragma unroll
                for (int k4 = 0; k4 < 4; ++k4) Sc[q][k4] = Sn[q][k4];
        }
        __syncthreads();
    } else {
        GLOADK(0); LSTOREK(0); GLOADV(0); LSTOREV(0); __syncthreads();
        for (int t = 0; t < nt; ++t) {
            f32x4 Sc[MQ][4];
            ATT_QK(Sc, lds, 0.f);
            if (KSC) {
#pragma unroll
                for (int k4 = 0; k4 < 4; ++k4) {
                    float4 sq = *(const float4*)(ksq + t * 64 + k4 * 16 + 4 * lg);
#pragma unroll
                    for (int pt = 1; pt < 4; ++pt) { const float4 s2 = *(const float4*)(ksq + pt * 8192 + t * 64 + k4 * 16 + 4 * lg); sq.x += s2.x; sq.y += s2.y; sq.z += s2.z; sq.w += s2.w; }
                    const float s0 = rsqrtf(sq.x * (1.f / 256.f) + EPS), s1 = rsqrtf(sq.y * (1.f / 256.f) + EPS), s2 = rsqrtf(sq.z * (1.f / 256.f) + EPS), s3 = rsqrtf(sq.w * (1.f / 256.f) + EPS);
#pragma unroll
                    for (int q = 0; q < MQ; ++q) { Sc[q][k4][0] = fmaf(Sc[q][k4][0], s0, -bnd); Sc[q][k4][1] = fmaf(Sc[q][k4][1], s1, -bnd); Sc[q][k4][2] = fmaf(Sc[q][k4][2], s2, -bnd); Sc[q][k4][3] = fmaf(Sc[q][k4][3], s3, -bnd); }
                }
            } else {
#pragma unroll
                for (int q = 0; q < MQ; ++q)
#pragma unroll
                    for (int k4 = 0; k4 < 4; ++k4) Sc[q][k4] -= bnd;
            }
            ATT_SOFTMAX(Sc);
            ATT_PV(lds);
            __syncthreads();
            if (t + 1 < nt) { GLOADK(t + 1); LSTOREK(0); GLOADV(t + 1); LSTOREV(0); __syncthreads(); }
        }
    }
#pragma unroll
    for (int q = 0; q < MQ; ++q) {
        float l = lsum[q]; l += __shfl_xor(l, 16); l += __shfl_xor(l, 32);
        const float inv = 1.f / l;
#pragma unroll
        for (int n = 0; n < E / 16; ++n) O[q][n] *= inv;
    }
}

__device__ __forceinline__ void rms_row(const float* __restrict__ src, const float* __restrict__ g, bf16_t* __restrict__ dst, int lane) {
    float4 v[4]; float ss = 0.f;
#pragma unroll
    for (int i = 0; i < 4; ++i) { v[i] = *(const float4*)(src + (i * 64 + lane) * 4); ss += v[i].x * v[i].x + v[i].y * v[i].y + v[i].z * v[i].z + v[i].w * v[i].w; }
#pragma unroll
    for (int o = 32; o > 0; o >>= 1) ss += __shfl_xor(ss, o);
    const float rstd = rsqrtf(ss * (1.f / 1024.f) + EPS);
#pragma unroll
    for (int i = 0; i < 4; ++i) { const float4 gg = *(const float4*)(g + (i * 64 + lane) * 4);
        st4bf(dst + (i * 64 + lane) * 4, v[i].x * rstd * gg.x, v[i].y * rstd * gg.y, v[i].z * rstd * gg.z, v[i].w * rstd * gg.w); }
}

template <bool PERM_GU>
__device__ __forceinline__ void transpose_w(const float* __restrict__ src, int K, int N, bf16_t* __restrict__ dst, char* lds) {
    float* T = (float*)lds;
    const int tid = opaque_tid(), tk = K / 64, tn = N / 64;
    for (int t = blockIdx.x; t < tk * tn; t += gridDim.x) {
        const int k0 = (t / tn) * 64, n0 = (t % tn) * 64;
#pragma unroll
        for (int i = 0; i < 16; ++i) { const int kr = (tid >> 6) + 4 * i, nc = tid & 63; T[kr * 65 + nc] = src[(size_t)(k0 + kr) * N + n0 + nc]; }
        __syncthreads();
        const int nl = tid >> 2, ks = (tid & 3) * 16;
        int n = n0 + nl;
        if (PERM_GU) { const int isup = n >= DFF ? 1 : 0; const int c = n - isup * DFF; n = (c >> 6) * 128 + ((c >> 5) & 1) * 64 + (((c >> 4) & 1) * 2 + isup) * 16 + (c & 15); }
        uint4 o0, o1;
        o0.x = pk2(T[(ks + 0) * 65 + nl], T[(ks + 1) * 65 + nl]); o0.y = pk2(T[(ks + 2) * 65 + nl], T[(ks + 3) * 65 + nl]);
        o0.z = pk2(T[(ks + 4) * 65 + nl], T[(ks + 5) * 65 + nl]); o0.w = pk2(T[(ks + 6) * 65 + nl], T[(ks + 7) * 65 + nl]);
        o1.x = pk2(T[(ks + 8) * 65 + nl], T[(ks + 9) * 65 + nl]); o1.y = pk2(T[(ks + 10) * 65 + nl], T[(ks + 11) * 65 + nl]);
        o1.z = pk2(T[(ks + 12) * 65 + nl], T[(ks + 13) * 65 + nl]); o1.w = pk2(T[(ks + 14) * 65 + nl], T[(ks + 15) * 65 + nl]);
        bf16_t* d = dst + (size_t)n * K + k0 + ks;
        *(uint4*)d = o0; *(uint4*)(d + 8) = o1;
        __syncthreads();
    }
}

__device__ __forceinline__ float2 cmul(float2 a, float2 b) { return make_float2(a.x * b.x - a.y * b.y, a.x * b.y + a.y * b.x); }
__device__ __forceinline__ void s5_prep(const Params& p, int g, int dir, char* lds) {
    float2* POW = (float2*)lds;
    float2* BB = POW + 33 * 64;
    float2* CC = BB + 64 * 16;
    float2* COEF = CC + 16 * 64;
    const int tid = opaque_tid();
    const int gd = dir * 64 + g;
    if (tid < 64) {
        const int pp = tid;
        const float lre = p.lam_re[gd * 64 + pp], lim = p.lam_im[gd * 64 + pp];
        const float dt = expf(p.log_dt[gd]);
        for (int d = 0; d <= 32; ++d) { const float mag = expf((float)d * lre * dt); float sn, cs; sincosf((float)d * lim * dt, &sn, &cs); POW[d * 64 + pp] = make_float2(mag * cs, mag * sn); }
        const float a = lre * dt, b = lim * dt; float sn, cs, sh, ch; sincosf(b, &sn, &cs); sincosf(0.5f * b, &sh, &ch);
        const float nr = expm1f(a) * cs - 2.f * sh * sh, ni = expf(a) * sn;
        const float den = 1.f / (lre * lre + lim * lim);
        COEF[pp] = make_float2((nr * lre + ni * lim) * den, (ni * lre - nr * lim) * den);
    }
    __syncthreads();
    for (int i = tid; i < 1024; i += 256) {
        const int pp = i >> 4, h = i & 15;
        BB[i] = cmul(COEF[pp], make_float2(p.b_re[(gd * 64 + pp) * 16 + h], p.b_im[(gd * 64 + pp) * 16 + h]));
        const int hh = i >> 6, p2 = i & 63;
        CC[i] = make_float2(p.c_re[(gd * 16 + hh) * 64 + p2], p.c_im[(gd * 16 + hh) * 64 + p2]);
    }
    __syncthreads();
    float* Kc = (float*)(p.ws + OFF_KC) + (size_t)(g * 2 + dir) * 32 * 256;
    { const int hp = tid >> 4, h = tid & 15;
      float sacc[32];
#pragma unroll
      for (int d = 0; d < 32; ++d) sacc[d] = 0.f;
#pragma unroll 1
      for (int pp = 0; pp < 64; ++pp) { const float2 wcb = cmul(CC[hp * 64 + pp], BB[pp * 16 + h]);
#pragma unroll
          for (int d = 0; d < 32; ++d) { const float2 pw = POW[d * 64 + pp]; sacc[d] += wcb.x * pw.x - wcb.y * pw.y; } }
#pragma unroll
      for (int d = 0; d < 32; ++d) Kc[d * 256 + tid] = sacc[d]; }
    bf16_t* MA = (bf16_t*)(p.ws + OFF_MA) + ((size_t)g * 256 + dir * 128) * 512;
    for (int i = tid; i < 128 * 512; i += 256) {
        const int k = i & 511, nl = i >> 9, pp = nl >> 1, c = nl & 1, j = k >> 4, h = k & 15;
        const float2 w = cmul(POW[(dir == 0 ? 31 - j : j) * 64 + pp], BB[pp * 16 + h]);
        const float v = c == 0 ? w.x : w.y;
        MA[(size_t)nl * 512 + k] = (bf16_t)(pk2(v, 0.f) & 0xffff);
    }
    bf16_t* MTC = (bf16_t*)(p.ws + OFF_MTC) + (size_t)g * 512 * 768 + 512 + dir * 128;
    for (int i = tid; i < 512 * 128; i += 256) {
        const int cl = i & 127, row = i >> 7, pp = cl >> 1, c = cl & 1, ii = row >> 4, hp = row & 15;
        const float2 w = cmul(CC[hp * 64 + pp], POW[(dir == 0 ? ii + 1 : 32 - ii) * 64 + pp]);
        const float v = c == 0 ? w.x : -w.y;
        MTC[(size_t)row * 768 + cl] = (bf16_t)(pk2(v, 0.f) & 0xffff);
    }
    __syncthreads();
}

#ifndef DIFF_MQ
#define DIFF_MQ 2
#endif
#ifndef MEM_MQ
#define MEM_MQ 1
#endif
#ifndef PM
#define PM 0xffff
#endif
#define GRID_SYNC() do { asm volatile("s_waitcnt vmcnt(0)" ::: "memory"); grid.sync(); } while (0)
__global__ void __launch_bounds__(256, 2) fwd_megakernel(Params p) {
    cg::grid_group grid = cg::this_grid();
    extern __shared__ __attribute__((aligned(16))) char smem[];
    const int nb = gridDim.x, bid = blockIdx.x;
    char* ws = p.ws;
    bf16_t* WT_IN = (bf16_t*)(ws + OFF_WT_IN); bf16_t* WT_GLU = (bf16_t*)(ws + OFF_WT_GLU); bf16_t* WT_MKV = (bf16_t*)(ws + OFF_WT_MKV);
    bf16_t* WT_BR = (bf16_t*)(ws + OFF_WT_BR); bf16_t* WT_OUT = (bf16_t*)(ws + OFF_WT_OUT); bf16_t* WT_GU = (bf16_t*)(ws + OFF_WT_GU); bf16_t* WT_DN = (bf16_t*)(ws + OFF_WT_DN);
    float* ROPE = (float*)(ws + OFF_ROPE); float* SSQK = (float*)(ws + OFF_SSQK);
    bf16_t* MEMN = (bf16_t*)(ws + OFF_MEMN); bf16_t* MEMK = (bf16_t*)(ws + OFF_MEMK); bf16_t* MEMVT = (bf16_t*)(ws + OFF_MEMVT);
    bf16_t* Hh = (bf16_t*)(ws + OFF_H); bf16_t* Ub = (bf16_t*)(ws + OFF_U); bf16_t* Qb = (bf16_t*)(ws + OFF_Q); bf16_t* Kb = (bf16_t*)(ws + OFF_K);
    bf16_t* MA = (bf16_t*)(ws + OFF_MA); bf16_t* MTC = (bf16_t*)(ws + OFF_MTC); bf16_t* CAR = (bf16_t*)(ws + OFF_CAR);
    bf16_t* Zb = (bf16_t*)(ws + OFF_Z); bf16_t* S5O = (bf16_t*)(ws + OFF_S5OUT); bf16_t* MRG = (bf16_t*)(ws + OFF_MERGED); bf16_t* ACT = (bf16_t*)(ws + OFF_ACT); bf16_t* H2 = (bf16_t*)(ws + OFF_H2);
    bf16_t* QM = (bf16_t*)((char*)p.out + DOFF_QM); bf16_t* VT = (bf16_t*)((char*)p.out + DOFF_VT); bf16_t* HR = VT;

    transpose_w<false>(p.w_in, 1024, 8192, WT_IN, smem);
    transpose_w<false>(p.w_glu, 1024, 1024, WT_GLU, smem);
    transpose_w<false>(p.w_mkv, 1024, 2048, WT_MKV, smem);
    for (int n3 = 0; n3 < 3; ++n3) transpose_w<false>(p.w_branch + (size_t)n3 * 1024 * 1024, 1024, 1024, WT_BR + (size_t)n3 * 1024 * 1024, smem);
    transpose_w<false>(p.w_out, 1024, 1024, WT_OUT, smem);
    transpose_w<true>(p.w_gu, 1024, 2 * DFF, WT_GU, smem);
    transpose_w<false>(p.w_dn, DFF, 1024, WT_DN, smem);
    for (int it = bid; it < TT / 4; it += nb) { PHASE_IDS const int t = it * 4 + w; const float* src = t < TP ? p.x_p + (size_t)t * DM : p.x_s + (size_t)(t - TP) * DM; rms_row(src, p.norm_mix_g, Hh + (size_t)t * DM, lane); }
    for (int it = bid; it < 8192 / 4; it += nb) { PHASE_IDS const int r = it * 4 + w; const float* src = r < 4096 ? p.mem_p + (size_t)r * DM : p.mem_s + (size_t)(r - 4096) * DM; rms_row(src, p.mem_norm_g, MEMN + (size_t)r * DM, lane); }
    for (int it = bid; it < 4096 * 32 / 256; it += nb) { PHASE_IDS const int i = it * 256 + tid, pos = i >> 5, d = i & 31;
        const float inv = powf(10000.f, -(float)d / 32.f); float sn, cs; sincosf((float)pos * inv, &sn, &cs); ROPE[pos * 64 + d] = cs; ROPE[pos * 64 + 32 + d] = sn; }
    if (PM & 4) for (int it = bid; it < 128; it += nb) s5_prep(p, it >> 1, it & 1, smem);
    GRID_SYNC();

    {
        const int n_in = (TT / BM) * 40, n_mkv = (8192 / BM) * 16, n_exp = 64 * 512 * 64 / 256;
        for (int it = bid; it < n_in + n_mkv + n_exp; it += nb) {
            PHASE_IDS
            if (it < n_in) {
                const int mt = it / 40, nt = it % 40, seg = nt >> 3, row0 = mt * BM, n0 = nt * 128;
                APlain af{Hh, DM};
                int s0, L; seq_info(row0, s0, L);
                if (seg == 3) {
                    f32x4 acc[MT][4]; zero_acc<4>(acc);
                    gemm_main<4, false>(acc, af, row0, WT_IN, DM, n0, DM, smem);
#pragma unroll
                    for (int m = 0; m < MT; ++m)
#pragma unroll
                        for (int n = 0; n < 4; ++n) { const int pos = row0 - s0 + wr * WM + m * 16 + 4 * lg, col = (nt & 7) * 128 + wc * 64 + n * 16 + lr;
                            st4bf(VT + (size_t)s0 * DM + (size_t)col * L + pos, acc[m][n][0], acc[m][n][1], acc[m][n][2], acc[m][n][3]); }
                } else {
                    f32x4 acc[MT][4]; zero_acc<4>(acc);
                    gemm_main<4, true>(acc, af, row0, WT_IN, DM, n0, DM, smem);
                    const int cb = (nt & 7) * 128 + wc * 64 + 4 * lg;
                    if (seg == 0) {
#pragma unroll
                        for (int m = 0; m < MT; ++m) { const int row = row0 + wr * WM + m * 16 + lr;
#pragma unroll
                            for (int n = 0; n < 4; ++n) { const int g = (nt & 7) * 8 + wc * 4 + n;
                                st4bf(Ub + ((size_t)g * NCH + (row >> 5)) * 512 + (row & 31) * 16 + 4 * lg, acc[m][n][0], acc[m][n][1], acc[m][n][2], acc[m][n][3]); } }
                    } else if (seg == 4) {
#pragma unroll
                        for (int m = 0; m < MT; ++m) { const int row = row0 + wr * WM + m * 16 + lr;
#pragma unroll
                            for (int n = 0; n < 4; ++n) st4bf(QM + (size_t)row * DM + cb + n * 16, acc[m][n][0], acc[m][n][1], acc[m][n][2], acc[m][n][3]); }
                    } else {
                        const float* gain = seg == 1 ? p.q_g : p.k_g; bf16_t* dst = seg == 1 ? Qb : Kb;
                        const float osc = seg == 1 ? 0.125f * 1.4426950408889634f : 1.f;
                        f32x4 gn[4];
#pragma unroll
                        for (int n = 0; n < 4; ++n) gn[n] = *(const f32x4*)(gain + n * 16 + 4 * lg);
#pragma unroll
                        for (int m = 0; m < MT; ++m) { const int row = row0 + wr * WM + m * 16 + lr, pos = row - s0;
                            float ss = 0.f;
#pragma unroll
                            for (int n = 0; n < 4; ++n)
#pragma unroll
                                for (int j = 0; j < 4; ++j) ss += acc[m][n][j] * acc[m][n][j];
                            ss += __shfl_xor(ss, 16); ss += __shfl_xor(ss, 32);
                            const float rstd = rsqrtf(ss * (1.f / 64.f) + EPS);
                            f32x4 o[4];
#pragma unroll
                            for (int n = 0; n < 2; ++n) { const f32x4 cs = *(const f32x4*)(ROPE + pos * 64 + n * 16 + 4 * lg), sn = *(const f32x4*)(ROPE + pos * 64 + 32 + n * 16 + 4 * lg);
#pragma unroll
                                for (int j = 0; j < 4; ++j) { const float x1 = acc[m][n][j] * rstd * gn[n][j], x2 = acc[m][n + 2][j] * rstd * gn[n + 2][j];
                                    o[n][j] = (x1 * cs[j] - x2 * sn[j]) * osc; o[n + 2][j] = (x1 * sn[j] + x2 * cs[j]) * osc; } }
#pragma unroll
                            for (int n = 0; n < 4; ++n) st4bf(dst + (size_t)row * DM + cb + n * 16, o[n][0], o[n][1], o[n][2], o[n][3]); }
                    }
                }
            } else if (it < n_in + n_mkv) {
                const int i2 = it - n_in, mt = i2 / 16, nt = i2 % 16, row0 = mt * BM, n0 = nt * 128;
                APlain af{MEMN, DM};
                if (nt < 8) {
                    f32x4 acc[MT][4]; zero_acc<4>(acc);
                    gemm_main<4, true>(acc, af, row0, WT_MKV, DM, n0, DM, smem);
                    const int cb = nt * 128 + wc * 64 + 4 * lg, head = nt >> 1;
#pragma unroll
                    for (int m = 0; m < MT; ++m) { const int row = row0 + wr * WM + m * 16 + lr; float ss = 0.f;
#pragma unroll
                        for (int n = 0; n < 4; ++n) { st4bf(MEMK + (size_t)row * DM + cb + n * 16, acc[m][n][0], acc[m][n][1], acc[m][n][2], acc[m][n][3]);
#pragma unroll
                            for (int j = 0; j < 4; ++j) ss += acc[m][n][j] * acc[m][n][j]; }
                        ss += __shfl_xor(ss, 16); ss += __shfl_xor(ss, 32);
                        if (lg == 0) SSQK[(head * 4 + (nt & 1) * 2 + wc) * 8192 + row] = ss; }
                } else {
                    f32x4 acc[MT][4]; zero_acc<4>(acc);
                    gemm_main<4, false>(acc, af, row0, WT_MKV, DM, n0, DM, smem);
#pragma unroll
                    for (int m = 0; m < MT; ++m)
#pragma unroll
                        for (int n = 0; n < 4; ++n) { const int row = row0 + wr * WM + m * 16 + 4 * lg, b = row >> 8, key = row & 255, col = (nt - 8) * 128 + wc * 64 + n * 16 + lr;
                            st4bf(MEMVT + ((size_t)b * 1024 + col) * 256 + key, acc[m][n][0], acc[m][n][1], acc[m][n][2], acc[m][n][3]); }
                }
            } else {
                const int i3 = (it - n_in - n_mkv) * 256 + tid;
                const int g = i3 >> 15, row = (i3 >> 6) & 511, kc = i3 & 63, ii = row >> 4, hp = row & 15, j = kc >> 1, h0 = (kc & 1) * 8;
                const float* Kc = (const float*)(ws + OFF_KC) + (size_t)g * 2 * 32 * 256;
                float v[8];
#pragma unroll
                for (int e = 0; e < 8; ++e) v[e] = 0.f;
                if (j <= ii) { const float* s = Kc + (ii - j) * 256 + hp * 16 + h0;
#pragma unroll
                    for (int e = 0; e < 8; ++e) v[e] += s[e]; }
                if (j >= ii) { const float* s = Kc + 32 * 256 + (j - ii) * 256 + hp * 16 + h0;
#pragma unroll
                    for (int e = 0; e < 8; ++e) v[e] += s[e]; }
                if (j == ii) {
#pragma unroll
                    for (int e = 0; e < 8; ++e) if (h0 + e == hp) v[e] += p.s5_d[g * 16 + hp]; }
                uint4 o; o.x = pk2(v[0], v[1]); o.y = pk2(v[2], v[3]); o.z = pk2(v[4], v[5]); o.w = pk2(v[6], v[7]);
                *(uint4*)(MTC + ((size_t)g * 512 + row) * 768 + j * 16 + h0) = o;
            }
        }
    }
    GRID_SYNC();

    for (int it = bid; it < 64 * (NCH / BM) * 2; it += nb) {
        PHASE_IDS
        int g = it / ((NCH / BM) * 2), r = it % ((NCH / BM) * 2);
        if ((nb & 7) == 0 && (64 * (NCH / BM) * 2) % nb == 0) {
            const int lu = (it / nb) * (nb >> 3) + (bid >> 3); g = (lu / ((NCH / BM) * 2)) * 8 + (bid & 7); r = lu % ((NCH / BM) * 2); }
        const int ct = r >> 1, nt = r & 1;
        AS5 af{Ub, CAR, g};
        f32x4 acc[MT][4]; zero_acc<4>(acc);
        gemm_main<4, true>(acc, af, ct * BM, MA + (size_t)g * 256 * 512, 512, nt * 128, 512, smem);
#pragma unroll
        for (int m = 0; m < MT; ++m) { const int chunk = ct * BM + wr * WM + m * 16 + lr;
#pragma unroll
            for (int n = 0; n < 4; ++n) st4bf(CAR + ((size_t)g * NCH + chunk) * 256 + nt * 128 + wc * 64 + n * 16 + 4 * lg, acc[m][n][0], acc[m][n][1], acc[m][n][2], acc[m][n][3]); }
    }
    GRID_SYNC();

    for (int it = bid; it < 32 * 64 * 128 / 256; it += nb) {
        PHASE_IDS
        const int i = it * 256 + tid, pd = i & 127, g = (i >> 7) & 63, b = i >> 13, dir = pd >> 6, pp = pd & 63;
        const int gd = dir * 64 + g;
        const float dt = expf(p.log_dt[gd]);
        const float lre = p.lam_re[gd * 64 + pp], lim = p.lam_im[gd * 64 + pp];
        const float mag = expf(32.f * lre * dt); float sn, cs; sincosf(32.f * lim * dt, &sn, &cs);
        const float ar = mag * cs, ai = mag * sn;
        const int c0 = b < 16 ? b * 64 : 1024 + (b - 16) * 128, nc = b < 16 ? 64 : 128;
        unsigned* base = (unsigned*)(CAR + ((size_t)g * NCH + c0) * 256 + pd * 2);
        float sr = 0.f, si = 0.f;
        for (int c8 = 0; c8 < nc; c8 += 8) {
            unsigned ev[8];
#pragma unroll
            for (int u = 0; u < 8; ++u) { const int cc = dir == 0 ? c8 + u : nc - 1 - (c8 + u); ev[u] = base[(size_t)cc * 128]; }
#pragma unroll
            for (int u = 0; u < 8; ++u) { const int cc = dir == 0 ? c8 + u : nc - 1 - (c8 + u);
                base[(size_t)cc * 128] = pk2(sr, si);
                const float er = bflo(ev[u]), ei = bfhi(ev[u]);
                const float nr = ar * sr - ai * si + er, ni = ar * si + ai * sr + ei;
                sr = nr; si = ni; }
        }
    }
    GRID_SYNC();

    {
        constexpr int DQ = 64 * DIFF_MQ, NQS = 4096 / DQ, NQP = 2048 / DQ;
        const int n_ds = 16 * 8 * NQS, n_dp = 16 * 8 * NQP, n_s5 = 64 * (NCH / BM) * 4, n_mem = (TT / (MEM_MQ * 64)) * 4;
        if (PM & 1) for (int it = bid; it < n_ds + n_dp; it += nb) {
            PHASE_IDS
            {
                int b, h, qt, L, s0;
                if ((nb & 7) == 0 && (n_ds + n_dp) % nb == 0) {
                    const int xcd = bid & 7, slot = bid >> 3, spx = nb >> 3, rnd = it / nb;
                    const int lu = rnd * spx + slot;
                    const int per_s = 16 * NQS;
                    if (lu < per_s) { L = 4096; const int bh = (lu / NQS) * 8 + xcd; qt = lu % NQS; b = bh >> 3; h = bh & 7; s0 = TP + b * 4096; }
                    else { const int l2 = lu - per_s; L = 2048; const int bh = (l2 / NQP) * 8 + xcd; qt = l2 % NQP; b = bh >> 3; h = bh & 7; s0 = b * 2048; }
                } else
                if (it < n_ds) { L = 4096; b = it / (8 * NQS); const int r = it % (8 * NQS); h = r / NQS; qt = r % NQS; s0 = TP + b * 4096; }
                else { const int i2 = it - n_ds; L = 2048; b = i2 / (8 * NQP); const int r = i2 % (8 * NQP); h = r / NQP; qt = r % NQP; s0 = b * 2048; }
                const int q0 = s0 + qt * DQ + w * (16 * DIFF_MQ);
                float bnd;
                { float gq = fabsf(p.q_g[lane]), gk = fabsf(p.k_g[lane]);
#pragma unroll
                  for (int o = 32; o > 0; o >>= 1) { gq = fmaxf(gq, __shfl_xor(gq, o)); gk = fmaxf(gk, __shfl_xor(gk, o)); }
                  bnd = fminf(64.f * gq * gk * (0.125f * 1.4426950408889634f), 60.f); }
                f32x4 O[DIFF_MQ][8];
                {
                    bf16x8 Qf[DIFF_MQ][2];
#pragma unroll
                    for (int mq = 0; mq < DIFF_MQ; ++mq)
#pragma unroll
                        for (int kk = 0; kk < 2; ++kk) Qf[mq][kk] = *(const bf16x8*)(Qb + (size_t)(q0 + mq * 16 + lr) * DM + (2 * h) * 64 + kk * 32 + lg * 8);
                    attn_pass<64, 128, DIFF_MQ, false, true>(O, Qf, Kb + (size_t)s0 * DM + (2 * h) * 64, DM, VT + (size_t)s0 * DM + (size_t)(h * 128) * L, L, L, nullptr, bnd, smem);
#pragma unroll
                    for (int mq = 0; mq < DIFF_MQ; ++mq)
#pragma unroll
                        for (int kk = 0; kk < 2; ++kk) Qf[mq][kk] = *(const bf16x8*)(Qb + (size_t)(q0 + mq * 16 + lr) * DM + (2 * h + 1) * 64 + kk * 32 + lg * 8);
                    asm volatile("s_waitcnt vmcnt(0)" ::: "memory");
#pragma unroll
                    for (int mq = 0; mq < DIFF_MQ; ++mq)
#pragma unroll
                        for (int n = 0; n < 8; ++n) { uint2 v; v.x = pk2(O[mq][n][0], O[mq][n][1]); v.y = pk2(O[mq][n][2], O[mq][n][3]);
#if ATT_PIPE == 2
                            *(uint2*)(Qb + (size_t)(q0 + mq * 16 + lr) * DM + h * 128 + n * 16 + 4 * lg) = v; }
#else
                            *(uint2*)(smem + 49152 + ((w * DIFF_MQ + mq) * 8 + n) * 512 + lane * 8) = v; }
#endif
                    __syncthreads();
                    attn_pass<64, 128, DIFF_MQ, false, true>(O, Qf, Kb + (size_t)s0 * DM + (2 * h + 1) * 64, DM, VT + (size_t)s0 * DM + (size_t)(h * 128) * L, L, L, nullptr, bnd, smem);
                }
                float d1 = p.lq1[lane] * p.lk1[lane], d2 = p.lq2[lane] * p.lk2[lane];
#pragma unroll
                for (int o = 32; o > 0; o >>= 1) { d1 += __shfl_xor(d1, o); d2 += __shfl_xor(d2, o); }
                const float lam = expf(d1) - expf(d2) + 0.2f;
#pragma unroll
                for (int mq = 0; mq < DIFF_MQ; ++mq) {
                    float ss = 0.f;
#pragma unroll
                    for (int n = 0; n < 8; ++n) {
#if ATT_PIPE == 2
                        uint2 o1; { const unsigned long long ov = __hip_atomic_load((const unsigned long long*)(Qb + (size_t)(q0 + mq * 16 + lr) * DM + h * 128 + n * 16 + 4 * lg), __ATOMIC_RELAXED, __HIP_MEMORY_SCOPE_AGENT); o1.x = (unsigned)ov; o1.y = (unsigned)(ov >> 32); }
#else
                        const uint2 o1 = *(const uint2*)(smem + 49152 + ((w * DIFF_MQ + mq) * 8 + n) * 512 + lane * 8);
#endif
                        O[mq][n][0] = bflo(o1.x) - lam * O[mq][n][0]; O[mq][n][1] = bfhi(o1.x) - lam * O[mq][n][1];
                        O[mq][n][2] = bflo(o1.y) - lam * O[mq][n][2]; O[mq][n][3] = bfhi(o1.y) - lam * O[mq][n][3];
#pragma unroll
                        for (int j = 0; j < 4; ++j) ss += O[mq][n][j] * O[mq][n][j];
                    }
                    ss += __shfl_xor(ss, 16); ss += __shfl_xor(ss, 32);
                    const float sc = rsqrtf(ss * (1.f / 128.f) + EPS) * 0.8f;
                    bf16_t* dst = Qb + (size_t)(q0 + mq * 16 + lr) * DM + h * 128 + 4 * lg;
#pragma unroll
                    for (int n = 0; n < 8; ++n) { const f32x4 sg = *(const f32x4*)(p.sub_g + n * 16 + 4 * lg);
                        st4bf(dst + n * 16, O[mq][n][0] * sc * sg[0], O[mq][n][1] * sc * sg[1], O[mq][n][2] * sc * sg[2], O[mq][n][3] * sc * sg[3]); }
                }
            }
        }
        for (int it = bid; it < n_s5; it += nb) {
            PHASE_IDS
            {
                int g = it / ((NCH / BM) * 4), r = it % ((NCH / BM) * 4);
                if ((nb & 7) == 0 && n_s5 % nb == 0) {
                    const int lu = (it / nb) * (nb >> 3) + (bid >> 3); g = (lu / ((NCH / BM) * 4)) * 8 + (bid & 7); r = lu % ((NCH / BM) * 4); }
                const int ct = r >> 2, nt = r & 3;
                AS5 af{Ub, CAR, g};
                f32x4 acc[MT][4]; zero_acc<4>(acc);
                gemm_main<4, true>(acc, af, ct * BM, MTC + (size_t)g * 512 * 768, 768, nt * 128, 768, smem);
#pragma unroll
                for (int m = 0; m < MT; ++m) { const int chunk = ct * BM + wr * WM + m * 16 + lr;
#pragma unroll
                    for (int n = 0; n < 4; ++n) { const int ii = nt * 8 + wc * 4 + n; const size_t tok = (size_t)chunk * 32 + ii;
                        st4bf(Zb + tok * DM + g * 16 + 4 * lg, gelu_tanh(acc[m][n][0]), gelu_tanh(acc[m][n][1]), gelu_tanh(acc[m][n][2]), gelu_tanh(acc[m][n][3])); } }
            }
        }
        if (PM & 2) for (int it = bid; it < n_mem; it += nb) {
            PHASE_IDS
            {
                const int i2 = it, tq = i2 >> 2, head = i2 & 3;
                const int t0 = tq * (MEM_MQ * 64); int s0, L; seq_info(t0, s0, L);
                const int b = t0 < TP ? t0 / 2048 : 16 + (t0 - TP) / 4096;
                float bnd;
                { float gg = 0.f;
#pragma unroll
                  for (int e = 0; e < 4; ++e) gg = fmaxf(gg, fabsf(p.mem_q_g[lane * 4 + e] * p.mem_k_g[lane * 4 + e]));
#pragma unroll
                  for (int o = 32; o > 0; o >>= 1) gg = fmaxf(gg, __shfl_xor(gg, o));
                  bnd = fminf(256.f * gg * (0.0625f * 1.4426950408889634f), 60.f); }
                bf16x8 Qf[MEM_MQ][8];
#pragma unroll
                for (int mq = 0; mq < MEM_MQ; ++mq) {
                    const int qrow = t0 + w * (MEM_MQ * 16) + mq * 16 + lr;
                    uint4 raw[8]; float ss = 0.f;
#pragma unroll
                    for (int kk = 0; kk < 8; ++kk) { raw[kk] = *(const uint4*)(QM + (size_t)qrow * DM + head * 256 + kk * 32 + lg * 8);
                        const unsigned ww[4] = {raw[kk].x, raw[kk].y, raw[kk].z, raw[kk].w};
#pragma unroll
                        for (int e = 0; e < 4; ++e) { const float a = bflo(ww[e]), c = bfhi(ww[e]); ss += a * a + c * c; } }
                    ss += __shfl_xor(ss, 16); ss += __shfl_xor(ss, 32);
                    const float sc = rsqrtf(ss * (1.f / 256.f) + EPS) * (0.0625f * 1.4426950408889634f);
#pragma unroll
                    for (int kk = 0; kk < 8; ++kk) { const int d0 = kk * 32 + lg * 8;
                        const unsigned ww[4] = {raw[kk].x, raw[kk].y, raw[kk].z, raw[kk].w}; unsigned oo[4];
#pragma unroll
                        for (int e = 0; e < 4; ++e) { const int d = d0 + 2 * e;
                            oo[e] = pk2(bflo(ww[e]) * sc * p.mem_q_g[d] * p.mem_k_g[d], bfhi(ww[e]) * sc * p.mem_q_g[d + 1] * p.mem_k_g[d + 1]); }
                        uint4 pw; pw.x = oo[0]; pw.y = oo[1]; pw.z = oo[2]; pw.w = oo[3]; Qf[mq][kk] = *(bf16x8*)&pw; }
                }
                f32x4 O[MEM_MQ][16];
                attn_pass<256, 256, MEM_MQ, true, false>(O, Qf, MEMK + (size_t)(b * 256) * DM + head * 256, DM, MEMVT + ((size_t)b * 1024 + head * 256) * 256, 256, 256,
                                                    SSQK + head * 4 * 8192 + b * 256, bnd, smem);
#pragma unroll
                for (int mq = 0; mq < MEM_MQ; ++mq) {
                    bf16_t* dst = QM + (size_t)(t0 + w * (MEM_MQ * 16) + mq * 16 + lr) * DM + head * 256 + 4 * lg;
#pragma unroll
                    for (int n = 0; n < 16; ++n) st4bf(dst + n * 16, O[mq][n][0], O[mq][n][1], O[mq][n][2], O[mq][n][3]);
                }
            }
        }
    }
    GRID_SYNC();

    {
        const int n_glu = (TT / BM) * 8;
        for (int it = bid; it < n_glu + TT / 4; it += nb) {
            PHASE_IDS
            if (it < n_glu) {
                const int mt = (it >> 6) * 8 + (it & 7), nt = (it >> 3) & 7, row0 = mt * BM, n0 = nt * 128;
                APlain af{Zb, DM};
                f32x4 acc[MT][4]; zero_acc<4>(acc);
                gemm_main<4, true>(acc, af, row0, WT_GLU, DM, n0, DM, smem);
#pragma unroll
                for (int m = 0; m < MT; ++m) { const int row = row0 + wr * WM + m * 16 + lr;
#pragma unroll
                    for (int n = 0; n < 4; ++n) { const size_t o = (size_t)row * DM + n0 + wc * 64 + n * 16 + 4 * lg; const uint2 zz = *(const uint2*)(Zb + o);
                        st4bf(S5O + o, bflo(zz.x) * sigmoidf_(acc[m][n][0]), bfhi(zz.x) * sigmoidf_(acc[m][n][1]), bflo(zz.y) * sigmoidf_(acc[m][n][2]), bfhi(zz.y) * sigmoidf_(acc[m][n][3])); } }
            } else {
                const int t = (it - n_glu) * 4 + w; const float* src = t < TP ? p.x_p + (size_t)t * DM : p.x_s + (size_t)(t - TP) * DM; rms_row(src, p.norm_mix_g, HR + (size_t)t * DM, lane);
            }
        }
    }
    GRID_SYNC();

    if (PM & 8) for (int it = bid; it < (TT / BM) * 8; it += nb) {
        PHASE_IDS
        const int mt = (it >> 6) * 8 + (it & 7), nt = (it >> 3) & 7, row0 = mt * BM, n0 = nt * 128;
#pragma unroll 1
        for (int n3 = 0; n3 < 3; ++n3) {
            unsigned gpk[MT][4][2];
            {
                f32x4 ga[MT][4]; zero_acc<4>(ga);
                APlain af{HR, DM}; gemm_main_pf<4, true, 2>(ga, af, row0, WT_IN + (size_t)(5120 + n3 * 1024) * DM, DM, n0, DM, smem);
#pragma unroll
                for (int n = 0; n < 4; ++n) { const f32x4 bg = *(const f32x4*)(p.b_gate + n3 * 1024 + n0 + wc * 64 + n * 16 + 4 * lg);
#pragma unroll
                    for (int m = 0; m < MT; ++m) { gpk[m][n][0] = pk2(sigmoidf_(ga[m][n][0] + bg[0]), sigmoidf_(ga[m][n][1] + bg[1]));
                                                   gpk[m][n][1] = pk2(sigmoidf_(ga[m][n][2] + bg[2]), sigmoidf_(ga[m][n][3] + bg[3])); } }
            }
            f32x4 ba[MT][4]; zero_acc<4>(ba);
            { APlain af{n3 == 0 ? S5O : (n3 == 1 ? Qb : QM), DM}; gemm_main_pf<4, true, 2>(ba, af, row0, WT_BR + (size_t)n3 * 1024 * 1024, DM, n0, DM, smem); }
#pragma unroll
            for (int m = 0; m < MT; ++m) { const int row = row0 + wr * WM + m * 16 + lr;
#pragma unroll
                for (int n = 0; n < 4; ++n) {
                    unsigned long long* dst = (unsigned long long*)(MRG + (size_t)row * DM + n0 + wc * 64 + n * 16 + 4 * lg);
                    unsigned lo = 0u, hi = 0u;
                    if (n3 > 0) { const unsigned long long old = __hip_atomic_load(dst, __ATOMIC_RELAXED, __HIP_MEMORY_SCOPE_AGENT); lo = (unsigned)old; hi = (unsigned)(old >> 32); }
                    lo = pk2(fmaf(bflo(gpk[m][n][0]), ba[m][n][0], bflo(lo)), fmaf(bfhi(gpk[m][n][0]), ba[m][n][1], bfhi(lo)));
                    hi = pk2(fmaf(bflo(gpk[m][n][1]), ba[m][n][2], bflo(hi)), fmaf(bfhi(gpk[m][n][1]), ba[m][n][3], bfhi(hi)));
                    *dst = ((unsigned long long)hi << 32) | lo; } }
        }
    }
    GRID_SYNC();

    for (int it = bid; it < (TT / BM) * 8; it += nb) {
        PHASE_IDS
        const int mt = (it >> 6) * 8 + (it & 7), nt = (it >> 3) & 7, row0 = mt * BM, n0 = nt * 128;
        APlain af{MRG, DM};
        f32x4 acc[MT][4]; zero_acc<4>(acc);
        gemm_main<4, true>(acc, af, row0, WT_OUT, DM, n0, DM, smem);
#pragma unroll
        for (int m = 0; m < MT; ++m) { const int row = row0 + wr * WM + m * 16 + lr;
            const float* xr = row < TP ? p.x_p + (size_t)row * DM : p.x_s + (size_t)(row - TP) * DM;
#pragma unroll
            for (int n = 0; n < 4; ++n) { const int col = n0 + wc * 64 + n * 16 + 4 * lg; const f32x4 xv = *(const f32x4*)(xr + col);
                *(f32x4*)(p.out + (size_t)row * DM + col) = xv + acc[m][n]; } }
    }
    GRID_SYNC();

    for (int it = bid; it < TT / 4; it += nb) { PHASE_IDS const int t = it * 4 + w; rms_row(p.out + (size_t)t * DM, p.ffn_norm_g, H2 + (size_t)t * DM, lane); }
    GRID_SYNC();

#ifdef REP9
    for (int rep = 0; rep < REP9; ++rep)
#endif
    for (int it = bid; it < (TT / BM) * 44; it += nb) {
        PHASE_IDS
        const int mt = it / 44, jt = it % 44, row0 = mt * BM, n0 = jt * 128;
        APlain af{H2, DM};
        f32x4 acc[MT][4]; zero_acc<4>(acc);
        gemm_main<4, true>(acc, af, row0, WT_GU, DM, n0, DM, smem);
#pragma unroll
        for (int m = 0; m < MT; ++m) { const int row = row0 + wr * WM + m * 16 + lr;
#pragma unroll
            for (int pi = 0; pi < 2; ++pi) { const f32x4 gg = acc[m][2 * pi], uu = acc[m][2 * pi + 1];
                st4bf(ACT + (size_t)row * DFF + jt * 64 + wc * 32 + pi * 16 + 4 * lg, gg[0] * sigmoidf_(gg[0]) * uu[0], gg[1] * sigmoidf_(gg[1]) * uu[1], gg[2] * sigmoidf_(gg[2]) * uu[2], gg[3] * sigmoidf_(gg[3]) * uu[3]); } }
    }
    GRID_SYNC();

    for (int it = bid; it < (TT / BM) * 8; it += nb) {
        PHASE_IDS
        const int mt = (it >> 6) * 8 + (it & 7), nt = (it >> 3) & 7, row0 = mt * BM, n0 = nt * 128;
        APlain af{ACT, DFF};
        f32x4 acc[MT][4]; zero_acc<4>(acc);
        gemm_main_pf<4, true, 2>(acc, af, row0, WT_DN, DFF, n0, DFF, smem);
#pragma unroll
        for (int m = 0; m < MT; ++m) { const int row = row0 + wr * WM + m * 16 + lr;
#pragma unroll
            for (int n = 0; n < 4; ++n) { float* o = p.out + (size_t)row * DM + n0 + wc * 64 + n * 16 + 4 * lg; const f32x4 xv = *(const f32x4*)o; *(f32x4*)o = xv + acc[m][n]; } }
    }
}

extern "C" void kernel_launch(void* const* d_in, const int* in_sizes, int n_in, void* d_out, int out_size, void* d_ws, size_t ws_size, hipStream_t stream) {
    static int grid_blocks = 0;
    if (!grid_blocks) {
        int dev = 0, cus = 0, per_cu = 0;
        hipGetDevice(&dev);
        hipDeviceGetAttribute(&cus, hipDeviceAttributeMultiprocessorCount, dev);
        hipFuncSetAttribute((const void*)fwd_megakernel, hipFuncAttributeMaxDynamicSharedMemorySize, LDS_BYTES);
        hipOccupancyMaxActiveBlocksPerMultiprocessor(&per_cu, fwd_megakernel, 256, LDS_BYTES);
        if (per_cu > 2) per_cu = 2;
        if (per_cu < 1) per_cu = 1;
        grid_blocks = cus * per_cu;
    }
    if (ws_size < OFF_END) { fprintf(stderr, "workspace too small: %zu\n", ws_size); return; }
    Params p{};
    const float* const* in = (const float* const*)d_in;
    p.x_p = in[0]; p.x_s = in[1]; p.mem_p = in[2]; p.mem_s = in[3]; p.norm_mix_g = in[4]; p.w_in = in[5]; p.b_gate = in[6];
    p.lam_re = in[7]; p.lam_im = in[8]; p.log_dt = in[9]; p.b_re = in[10]; p.b_im = in[11]; p.c_re = in[12]; p.c_im = in[13];
    p.s5_d = in[14]; p.w_glu = in[15]; p.q_g = in[16]; p.k_g = in[17]; p.lq1 = in[18]; p.lk1 = in[19]; p.lq2 = in[20]; p.lk2 = in[21]; p.sub_g = in[22];
    p.mem_norm_g = in[23]; p.w_mkv = in[24]; p.mem_q_g = in[25]; p.mem_k_g = in[26]; p.w_branch = in[27]; p.w_out = in[28]; p.ffn_norm_g = in[29];
    p.w_gu = in[30]; p.w_dn = in[31];
    p.out = (float*)d_out; p.ws = (char*)d_ws;
    void* args[] = {&p};
    hipError_t e = hipLaunchCooperativeKernel((void*)fwd_megakernel, dim3(grid_blocks), dim3(256), args, LDS_BYTES, stream);
    if (e != hipSuccess) fprintf(stderr, "cooperative launch failed: %s (grid %d)\n", hipGetErrorString(e), grid_blocks);
}
```
